# Optimizing an MI355X kernel written in HIP

```python
import jax
import jax.numpy as jnp
from jax import lax
import numpy as np

D_MODEL = 1024
BATCH = 8
SEQ = 2048
DEPTH = 4

N_META = 16
CHUNK = 64
PAD_FRONT = (-N_META) % CHUNK
BRANCH_WIDTH = 512
N_BRANCH = 4
D_FF = 4 * D_MODEL
NORM_EPS = 1e-6

RET_HEADS = 4
RET_DK = 64
RET_DV = 128
RET_ROPE_BASE = 10000.0

S5_GROUP = 16
S5_GROUPS = BRANCH_WIDTH // S5_GROUP
S5_STATE = 64

SSD_HEADDIM = 64
SSD_HEADS = BRANCH_WIDTH // SSD_HEADDIM
SSD_GROUPS = 2
SSD_STATE = 128
SSD_CONV = 4
SSD_CONV_DIM = BRANCH_WIDTH + 2 * SSD_GROUPS * SSD_STATE

HG_HEADS = 4
HG_DK = BRANCH_WIDTH // HG_HEADS
HG_DV = BRANCH_WIDTH // HG_HEADS

IN_SIZES = (RET_HEADS * RET_DK, RET_HEADS * RET_DK, RET_HEADS * RET_DV, RET_HEADS * RET_DV,
            BRANCH_WIDTH,
            BRANCH_WIDTH, SSD_CONV_DIM, SSD_HEADS,
            HG_HEADS * HG_DK, HG_HEADS * HG_DK, HG_HEADS * HG_DV, HG_HEADS * HG_DV,
            N_BRANCH * D_MODEL)
IN_DIM = sum(IN_SIZES)

kernel_name = 'hybrid_ret_s5_ssd_hgrn2_trunk'


def rms_norm(x, w):
    xf = x.astype(jnp.float32)
    y = xf * lax.rsqrt(jnp.mean(xf * xf, axis=-1, keepdims=True) + NORM_EPS)
    return (y * w.astype(jnp.float32)).astype(x.dtype)


def to_chunks(t):
    pad = [(0, 0)] * t.ndim
    pad[1] = (PAD_FRONT, 0)
    t = jnp.pad(t, pad)
    b, tt = t.shape[0], t.shape[1]
    t = t.reshape((b, tt // CHUNK, CHUNK) + t.shape[2:])
    return jnp.moveaxis(t, 1, 0)


def from_chunks(y):
    y = jnp.moveaxis(y, 0, 1)
    b, n = y.shape[0], y.shape[1]
    y = y.reshape((b, n * CHUNK) + y.shape[3:])
    return y[:, PAD_FRONT:]


def chunked_scalar_decay_attention(q, k, v, log_a):
    b, _, g, dk = q.shape
    hg, dv = v.shape[3], v.shape[4]
    causal = jnp.tril(jnp.ones((CHUNK, CHUNK), dtype=bool))[None, :, :, None, None]

    def step(state, inp):
        qc, kc, vc, lac = inp
        cum = jnp.cumsum(lac.astype(jnp.float32), axis=1)
        seg = cum[:, :, None] - cum[:, None, :]
        decay = jnp.exp(jnp.where(causal, seg, -jnp.inf)).astype(qc.dtype)
        scores = jnp.einsum('btgd,bsgd->btsg', qc, kc)
        y_in = jnp.einsum('btsgh,bsghe->btghe', scores[..., None] * decay, vc)
        y_x = jnp.einsum('btgd,bghde->btghe', qc, state) * jnp.exp(cum)[..., None]
        last = cum[:, -1]
        w = jnp.exp(last[:, None] - cum).astype(kc.dtype)
        state = state * jnp.exp(last)[..., None, None] + jnp.einsum('bsgd,bsgh,bsghe->bghde', kc, w, vc)
        return state, y_in + y_x

    state0 = jnp.zeros((b, g, hg, dk, dv), jnp.float32)
    _, y = lax.scan(step, state0, (to_chunks(q), to_chunks(k), to_chunks(v), to_chunks(log_a)))
    return from_chunks(y).astype(v.dtype)


def chunked_vector_decay_attention(q, k, v, log_f):
    b, _, h, dk = q.shape
    dv = v.shape[-1]
    causal = jnp.tril(jnp.ones((CHUNK, CHUNK), dtype=bool))[None, :, :, None, None]

    def step(state, inp):
        qc, kc, vc, lfc = inp
        cum = jnp.cumsum(lfc.astype(jnp.float32), axis=1)
        decay = jnp.exp(jnp.where(causal, cum[:, :, None] - cum[:, None, :], -jnp.inf)).astype(qc.dtype)
        scores = jnp.einsum('bthd,bshd,btshd->btsh', qc, kc, decay)
        y_in = jnp.einsum('btsh,bshe->bthe', scores, vc)
        y_x = jnp.einsum('bthd,bhde->bthe', qc * jnp.exp(cum).astype(qc.dtype), state)
        last = cum[:, -1]
        kw = kc * jnp.exp(last[:, None] - cum).astype(kc.dtype)
        state = state * jnp.exp(last)[..., None] + jnp.einsum('bshd,bshe->bhde', kw, vc)
        return state, y_in + y_x

    state0 = jnp.zeros((b, h, dk, dv), jnp.float32)
    _, y = lax.scan(step, state0, (to_chunks(q), to_chunks(k), to_chunks(v), to_chunks(log_f)))
    return from_chunks(y).astype(v.dtype)


def rotary(x):
    t, dk = x.shape[1], x.shape[-1]
    half = dk // 2
    inv_freq = RET_ROPE_BASE ** (-jnp.arange(half, dtype=jnp.float32) / half)
    ang = jnp.arange(t, dtype=jnp.float32)[:, None] * inv_freq[None, :]
    cos = jnp.cos(ang)[None, :, None, :].astype(x.dtype)
    sin = jnp.sin(ang)[None, :, None, :].astype(x.dtype)
    x1, x2 = x[..., :half], x[..., half:]
    return jnp.concatenate([x1 * cos - x2 * sin, x1 * sin + x2 * cos], axis=-1)


def retention_mixer(q, k, v, g, gn_w):
    bsz, t, _ = q.shape
    q = rotary(q.reshape(bsz, t, RET_HEADS, RET_DK))
    k = rotary(k.reshape(bsz, t, RET_HEADS, RET_DK)) * RET_DK ** -0.5
    v = v.reshape(bsz, t, RET_HEADS, 1, RET_DV)
    gamma = 1.0 - jnp.exp2(-5.0 - jnp.arange(RET_HEADS, dtype=jnp.float32))
    log_a = jnp.broadcast_to(jnp.log(gamma)[:, None], (bsz, t, RET_HEADS, 1))
    y = chunked_scalar_decay_attention(q, k, v, log_a).reshape(bsz, t, RET_HEADS, RET_DV)
    yf = y.astype(jnp.float32)
    mu = jnp.mean(yf, axis=-1, keepdims=True)
    var = jnp.mean(jnp.square(yf - mu), axis=-1, keepdims=True)
    yn = ((yf - mu) * lax.rsqrt(var + NORM_EPS)).reshape(bsz, t, BRANCH_WIDTH) * gn_w.astype(jnp.float32)
    return jax.nn.silu(g) * yn.astype(g.dtype)


def s5_mixer(u, lam_re, lam_im, b_re, b_im, c_re, c_im, d_skip, log_step, glu_w, glu_b):
    bsz, t, _ = u.shape
    uf = u.astype(jnp.float32).reshape(bsz, t, S5_GROUPS, S5_GROUP)
    step = jnp.exp(log_step.astype(jnp.float32))[:, None]
    lr, li = lam_re.astype(jnp.float32), lam_im.astype(jnp.float32)
    mag = jnp.exp(lr * step)
    ab_re, ab_im = mag * jnp.cos(li * step), mag * jnp.sin(li * step)
    inv = 1.0 / (lr * lr + li * li)
    co_re = ((ab_re - 1.0) * lr + ab_im * li) * inv
    co_im = (ab_im * lr - (ab_re - 1.0) * li) * inv
    br, bi = b_re.astype(jnp.float32), b_im.astype(jnp.float32)
    bb_re = co_re[..., None] * br - co_im[..., None] * bi
    bb_im = co_re[..., None] * bi + co_im[..., None] * br
    bu_re = jnp.einsum('btgj,gpj->btgp', uf, bb_re)
    bu_im = jnp.einsum('btgj,gpj->btgp', uf, bb_im)
    a_re = jnp.broadcast_to(ab_re, bu_re.shape)
    a_im = jnp.broadcast_to(ab_im, bu_im.shape)

    def combine(e1, e2):
        a1r, a1i, b1r, b1i = e1
        a2r, a2i, b2r, b2i = e2
        return (a2r * a1r - a2i * a1i, a2r * a1i + a2i * a1r,
                a2r * b1r - a2i * b1i + b2r, a2r * b1i + a2i * b1r + b2i)

    _, _, xr, xi = lax.associative_scan(combine, (a_re, a_im, bu_re, bu_im), axis=1)
    y = (jnp.einsum('btgp,gjp->btgj', xr, c_re.astype(jnp.float32))
         - jnp.einsum('btgp,gjp->btgj', xi, c_im.astype(jnp.float32)))
    y = y.reshape(bsz, t, BRANCH_WIDTH) + d_skip.astype(jnp.float32) * u.astype(jnp.float32)
    y = jax.nn.gelu(y).astype(u.dtype)
    a, gt = jnp.split(y @ glu_w + glu_b, 2, axis=-1)
    return a * jax.nn.sigmoid(gt)


def ssd_mixer(z, xbc, dt_raw, conv_w, conv_b, dt_bias, a_log, d_skip, norm_w):
    bsz, t, _ = z.shape
    hg = SSD_HEADS // SSD_GROUPS
    xbc = lax.conv_general_dilated(xbc, conv_w[:, None, :], window_strides=(1,), padding=[(SSD_CONV - 1, 0)],
                                   dimension_numbers=('NWC', 'WIO', 'NWC'),
                                   feature_group_count=SSD_CONV_DIM) + conv_b
    xbc = jax.nn.silu(xbc)
    xs, bm, cm = jnp.split(xbc, [BRANCH_WIDTH, BRANCH_WIDTH + SSD_GROUPS * SSD_STATE], axis=-1)
    xs = xs.reshape(bsz, t, SSD_GROUPS, hg, SSD_HEADDIM)
    bm = bm.reshape(bsz, t, SSD_GROUPS, SSD_STATE)
    cm = cm.reshape(bsz, t, SSD_GROUPS, SSD_STATE)
    dt = jax.nn.softplus((dt_raw + dt_bias).astype(jnp.float32)).reshape(bsz, t, SSD_GROUPS, hg)
    a = -jnp.exp(a_log.astype(jnp.float32)).reshape(SSD_GROUPS, hg)
    y = chunked_scalar_decay_attention(cm, bm, xs * dt[..., None].astype(xs.dtype), dt * a)
    y = y + d_skip.reshape(SSD_GROUPS, hg)[..., None] * xs
    y = y.reshape(bsz, t, BRANCH_WIDTH) * jax.nn.silu(z)
    y = rms_norm(y.reshape(bsz, t, SSD_GROUPS, -1), norm_w.reshape(SSD_GROUPS, -1))
    return y.reshape(bsz, t, BRANCH_WIDTH)


def hgrn2_mixer(q, f_raw, i, g, lb, norm_w):
    bsz, t, _ = q.shape
    q = jax.nn.silu(q).reshape(bsz, t, HG_HEADS, HG_DK)
    f = lb + (1.0 - lb) * jax.nn.sigmoid(f_raw.astype(jnp.float32))
    log_f = jnp.log(f).reshape(bsz, t, HG_HEADS, HG_DK)
    k = (1.0 - f).astype(q.dtype).reshape(bsz, t, HG_HEADS, HG_DK)
    v = i.reshape(bsz, t, HG_HEADS, HG_DV)
    o = chunked_vector_decay_attention(q, k, v, log_f)
    o = rms_norm(o, norm_w.reshape(HG_HEADS, HG_DV)).reshape(bsz, t, BRANCH_WIDTH)
    return o * jax.nn.silu(g)


def setup_inputs(seed: int = 0) -> dict:
    key = jax.random.key(seed)
    ks = jax.random.split(key, 32)
    f32 = jnp.float32

    def nrm(k, shape, scale):
        return jax.random.normal(k, shape, f32) * scale

    def gain(k, shape):
        return 1.0 + 0.05 * jax.random.normal(k, shape, f32)

    n = jnp.arange(S5_STATE, dtype=f32)
    dt0 = jnp.exp(jax.random.uniform(ks[24], (DEPTH, SSD_HEADS), f32, np.log(1e-3), np.log(1e-1)))
    return {
        'x': nrm(ks[0], (BATCH, SEQ, D_MODEL), 1.0),
        'meta_tokens': nrm(ks[1], (N_META, D_MODEL), 1.0),
        'w_in': nrm(ks[2], (DEPTH, D_MODEL, IN_DIM), D_MODEL ** -0.5),
        'w_branch': nrm(ks[3], (DEPTH, N_BRANCH, BRANCH_WIDTH, D_MODEL), BRANCH_WIDTH ** -0.5),
        'w_out': nrm(ks[4], (DEPTH, D_MODEL, D_MODEL), D_MODEL ** -0.5),
        'norm_pre_mix': gain(ks[5], (DEPTH, D_MODEL)),
        'norm_post_mix': gain(ks[6], (DEPTH, D_MODEL)),
        'norm_pre_mlp': gain(ks[7], (DEPTH, D_MODEL)),
        'norm_post_mlp': gain(ks[8], (DEPTH, D_MODEL)),
        'w_up': nrm(ks[9], (DEPTH, D_MODEL, D_FF), D_MODEL ** -0.5),
        'w_down': nrm(ks[10], (DEPTH, D_FF, D_MODEL), D_FF ** -0.5),
        'ret_gn_w': gain(ks[11], (DEPTH, BRANCH_WIDTH)),
        's5_lam_re': -0.5 + 0.01 * jax.random.normal(ks[12], (DEPTH, S5_GROUPS, S5_STATE), f32),
        's5_lam_im': jnp.pi * n + 0.01 * jax.random.normal(ks[13], (DEPTH, S5_GROUPS, S5_STATE), f32),
        's5_b_re': nrm(ks[14], (DEPTH, S5_GROUPS, S5_STATE, S5_GROUP), 1.0),
        's5_b_im': nrm(ks[15], (DEPTH, S5_GROUPS, S5_STATE, S5_GROUP), 1.0),
        's5_c_re': nrm(ks[16], (DEPTH, S5_GROUPS, S5_GROUP, S5_STATE), S5_STATE ** -0.5),
        's5_c_im': nrm(ks[17], (DEPTH, S5_GROUPS, S5_GROUP, S5_STATE), S5_STATE ** -0.5),
        's5_d': nrm(ks[18], (DEPTH, BRANCH_WIDTH), 1.0),
        's5_log_step': jax.random.uniform(ks[19], (DEPTH, S5_GROUPS), f32, np.log(1e-3), np.log(1e-1)),
        's5_glu_w': nrm(ks[20], (DEPTH, BRANCH_WIDTH, 2 * BRANCH_WIDTH), BRANCH_WIDTH ** -0.5),
        's5_glu_b': nrm(ks[21], (DEPTH, 2 * BRANCH_WIDTH), 0.02),
        'ssd_conv_w': nrm(ks[22], (DEPTH, SSD_CONV, SSD_CONV_DIM), SSD_CONV ** -0.5),
        'ssd_conv_b': nrm(ks[23], (DEPTH, SSD_CONV_DIM), 0.02),
        'ssd_dt_bias': dt0 + jnp.log(-jnp.expm1(-dt0)),
        'ssd_a_log': jnp.log(jax.random.uniform(ks[25], (DEPTH, SSD_HEADS), f32, 1.0, 16.0)),
        'ssd_d': gain(ks[26], (DEPTH, SSD_HEADS)),
        'ssd_norm_w': gain(ks[27], (DEPTH, BRANCH_WIDTH)),
        'hgrn_lb': nrm(ks[28], (DEPTH, HG_HEADS * HG_DK), 0.1),
        'hgrn_norm_w': gain(ks[29], (DEPTH, BRANCH_WIDTH)),
    }


def reference(x, meta_tokens, w_in, w_branch, w_out, norm_pre_mix, norm_post_mix, norm_pre_mlp, norm_post_mlp,
              w_up, w_down, ret_gn_w, s5_lam_re, s5_lam_im, s5_b_re, s5_b_im, s5_c_re, s5_c_im, s5_d,
              s5_log_step, s5_glu_w, s5_glu_b, ssd_conv_w, ssd_conv_b, ssd_dt_bias, ssd_a_log, ssd_d,
              ssd_norm_w, hgrn_lb, hgrn_norm_w):
    bsz = x.shape[0]
    meta = jnp.broadcast_to(meta_tokens[None].astype(x.dtype), (bsz, N_META, D_MODEL))
    h = jnp.concatenate([meta, x], axis=1)
    t = h.shape[1]
    lb_all = jnp.cumsum(jax.nn.softmax(hgrn_lb.astype(jnp.float32), axis=0), axis=0)
    lb_all = lb_all - lb_all[0]
    split_at = [int(s) for s in np.cumsum(IN_SIZES)[:-1]]
    for l in range(DEPTH):
        u = rms_norm(h, norm_pre_mix[l])
        proj = u @ w_in[l]
        (rq, rk, rv, rg, s5u, sz, sxbc, sdt, hq, hf, hi, hgate, gates) = jnp.split(proj, split_at, axis=-1)
        y_ret = retention_mixer(rq, rk, rv, rg, ret_gn_w[l])
        y_s5 = s5_mixer(s5u, s5_lam_re[l], s5_lam_im[l], s5_b_re[l], s5_b_im[l], s5_c_re[l], s5_c_im[l],
                        s5_d[l], s5_log_step[l], s5_glu_w[l], s5_glu_b[l])
        y_ssd = ssd_mixer(sz, sxbc, sdt, ssd_conv_w[l], ssd_conv_b[l], ssd_dt_bias[l], ssd_a_log[l],
                          ssd_d[l], ssd_norm_w[l])
        y_hg = hgrn2_mixer(hq, hf, hi, hgate, lb_all[l], hgrn_norm_w[l])
        branches = jnp.stack([y_ret, y_s5, y_ssd, y_hg], axis=2)
        proj_b = jnp.einsum('btnc,ncd->btnd', branches, w_branch[l])
        gate = jax.nn.sigmoid(gates.reshape(bsz, t, N_BRANCH, D_MODEL))
        mixed = jnp.sum(gate * proj_b, axis=2) @ w_out[l]
        h = h + rms_norm(mixed, norm_post_mix[l])
        m = rms_norm(h, norm_pre_mlp[l])
        m = jnp.square(jax.nn.relu(m @ w_up[l])) @ w_down[l]
        h = h + rms_norm(m, norm_post_mlp[l])
    return h[:, N_META:]
```

```cpp
#include <hip/hip_runtime.h>
#include <hip/hip_cooperative_groups.h>
#include <cstdio>
#include <cstdint>
namespace cg = cooperative_groups;

#define LAS __attribute__((address_space(3)))
typedef unsigned short bf16_t;
typedef short bf16x8 __attribute__((ext_vector_type(8)));
typedef float f32x4 __attribute__((ext_vector_type(4)));
typedef unsigned u32x4 __attribute__((ext_vector_type(4)));
typedef unsigned u32x2 __attribute__((ext_vector_type(2)));

#ifdef NOSYNC
#define GSYNC() __syncthreads()
#else
#define GSYNC() xcd_barrier(xb)
#endif
#ifndef NLAYERS_RUN
#define NLAYERS_RUN DEPTH
#endif
#ifndef EPIREP
#define EPIREP 0
#endif
#ifndef SYNCREP
#define SYNCREP 0
#endif
#ifndef MIXREP
#define MIXREP 0
#endif
#ifndef REPMASK
#define REPMASK 0
#endif
#ifndef PHMASK
#define PHMASK 0xFFFF
#endif
#ifndef FAST_RET
#define FAST_RET 1
#endif
#ifndef FAST_SSD
#define FAST_SSD 1
#endif
#ifndef FAST_HG
#define FAST_HG 1
#endif
#ifndef FAST_S5
#define FAST_S5 1
#endif

constexpr int NB = 8, SEQ = 2048, DM = 1024, DEPTH = 4, PADF = 48, TP = 2112  , MROWS = NB * TP  ;
constexpr int NPROJ = 9984, DFF = 4096, LDMX = 5632, LDG = 4096, LDDT = 256, LDBR = 2048;
constexpr float EPS = 1e-6f;
constexpr int RQ = 0, RK = 256, RV = 512, RG = 1024, S5U = 1536, SZ = 2048, SXBC = 2560, HQ = 3584, HF = 4096, HI = 4608, HGT = 5120;
constexpr size_t SZ_WIN = (size_t)NPROJ * 1024 * 2, SZ_WBR = (size_t)4 * 1024 * 512 * 2, SZ_WOUT = (size_t)1024 * 1024 * 2, SZ_WUP = (size_t)4096 * 1024 * 2, SZ_WDN = SZ_WUP, SZ_WGLU = (size_t)1024 * 512 * 2;
constexpr size_t WS_WIN = 0, WS_WBR = WS_WIN + SZ_WIN, WS_WOUT = WS_WBR + SZ_WBR, WS_WUP = WS_WOUT + SZ_WOUT, WS_WDN = WS_WUP + SZ_WUP, WS_WGLU = WS_WDN + SZ_WDN;
constexpr size_t WS_H = WS_WGLU + SZ_WGLU;
constexpr size_t WS_U = WS_H + (size_t)MROWS * 1024 * 4;
constexpr size_t WS_MX = WS_U + (size_t)MROWS * 1024 * 2;
constexpr size_t WS_G = WS_MX + (size_t)MROWS * LDMX * 2;
constexpr size_t WS_DT = WS_G + (size_t)MROWS * LDG * 2;
constexpr size_t WS_BR = WS_DT + (size_t)MROWS * LDDT * 2;
constexpr size_t WS_S5P = WS_BR + (size_t)MROWS * LDBR * 2;
constexpr size_t WS_END = WS_S5P + (size_t)MROWS * 512 * 2;
constexpr size_t WS_BAR = (WS_END + 255) & ~(size_t)255, WS_XBC = WS_BAR + 16384  , WS_TOTAL = WS_XBC + (size_t)MROWS * 1024 * 2;
constexpr size_t WS_MIXP = WS_MX;
constexpr size_t WS_DELTA = WS_MX + ((size_t)64 << 20);
static_assert(WS_DELTA + (size_t)MROWS * 1024 * 4 <= WS_G, "overlay");
constexpr int LDS_BYTES = 163840;

struct Params { const float* in[30]; float* out; unsigned char* ws; };
typedef const unsigned char __attribute__((address_space(4))) kbyte_t;
__device__ __forceinline__ Params fetch_params() {
#if defined(__HIP_DEVICE_COMPILE__)
    kbyte_t* k = (kbyte_t*)__builtin_amdgcn_kernarg_segment_ptr(); asm volatile("" : "+s"(k));
    typedef const unsigned long long __attribute__((address_space(4))) ku64_t;
    Params p;
#pragma unroll
    for (int i = 0; i < 30; ++i) p.in[i] = (const float*)(const float __attribute__((address_space(1)))*)((ku64_t*)k)[i];
    p.out = (float*)(float __attribute__((address_space(1)))*)((ku64_t*)k)[30]; p.ws = (unsigned char*)(unsigned char __attribute__((address_space(1)))*)((ku64_t*)k)[31];
    return p;
#else
    return Params{};
#endif
}

__device__ __forceinline__ int opaque_tid() { int t = threadIdx.x; asm volatile("" : "+v"(t)); return t; }
#define LDS_WAIT() asm volatile("s_waitcnt lgkmcnt(0)" ::: "memory")
#define LBAR() do { asm volatile("s_waitcnt lgkmcnt(0)" ::: "memory"); __builtin_amdgcn_s_barrier(); asm volatile("" ::: "memory"); } while (0)
typedef float f32x2_ __attribute__((ext_vector_type(2)));
typedef __bf16 bf16x2_ __attribute__((ext_vector_type(2)));
__device__ __forceinline__ unsigned pk2(float lo, float hi) { const f32x2_ v = {lo, hi}; return __builtin_bit_cast(unsigned, __builtin_convertvector(v, bf16x2_)); }
__device__ __forceinline__ unsigned f2bf(float f) { return (unsigned)__builtin_bit_cast(unsigned short, (__bf16)f); }
__device__ __forceinline__ float bf2f(unsigned b) { return __builtin_bit_cast(float, (b & 0xffffu) << 16); }
__device__ __forceinline__ float bflo(unsigned w) { return __builtin_bit_cast(float, w << 16); }
__device__ __forceinline__ float bfhi(unsigned w) { return __builtin_bit_cast(float, w & 0xffff0000u); }
__device__ __forceinline__ float wave_sum(float v) {
#pragma unroll
    for (int o = 1; o < 64; o <<= 1) v += __shfl_xor(v, o);
    return v;
}
__device__ __forceinline__ float sigmoidf_(float x) { return __builtin_amdgcn_rcpf(1.0f + __expf(-x)); }
__device__ __forceinline__ float siluf_(float x) { return x * __builtin_amdgcn_rcpf(1.0f + __expf(-x)); }
__device__ __forceinline__ float softplusf_(float x) { return x > 20.f ? x : log1pf(__expf(x)); }
__device__ __forceinline__ float geluf_(float x) { const float z = 0.7978845608f * (x + 0.044715f * x * x * x); const float e = __expf(2.f * z); const float th = 1.f - 2.f * __builtin_amdgcn_rcpf(e + 1.f); return 0.5f * x * (1.f + th); }
__device__ __forceinline__ void sincos_turns(float turns, float& s, float& c) { const float fr = turns - floorf(turns); s = __builtin_amdgcn_sinf(fr); c = __builtin_amdgcn_cosf(fr); }


__device__ __forceinline__ float gate_qf(float g) { return sigmoidf_(g) * 256.f - 0.5f; }
__device__ __forceinline__ unsigned gate_q8x4(float a, float b, float c, float d) {
    unsigned w = __builtin_amdgcn_cvt_pk_u8_f32(gate_qf(a), 0u, 0u); w = __builtin_amdgcn_cvt_pk_u8_f32(gate_qf(b), 1u, w); w = __builtin_amdgcn_cvt_pk_u8_f32(gate_qf(c), 2u, w); return __builtin_amdgcn_cvt_pk_u8_f32(gate_qf(d), 3u, w); }
__device__ __forceinline__ float gate_s(unsigned w, int byte) { return (float)((w >> (8 * byte)) & 255u) + 0.5f; }
#define XB_TMO      128
#define XB_XCNT(j)  (256  + 64 * (j))
#define XB_XSUB(j)  (1280 + 64 * (j))
#define XB_XGEN(j)  (2304 + 64 * (j))
#define XB_TOP      3328
#define XB_TOPGEN   3392
#define XCD_BAR_WORDS 3456
#define XB_SPIN_CAP (1u << 18)

__device__ __forceinline__ unsigned xb_ld(unsigned* p)              { return __hip_atomic_load(p, __ATOMIC_RELAXED, __HIP_MEMORY_SCOPE_AGENT); }
__device__ __forceinline__ unsigned xb_add(unsigned* p, unsigned v) { return __hip_atomic_fetch_add(p, v, __ATOMIC_RELAXED, __HIP_MEMORY_SCOPE_AGENT); }
__device__ __forceinline__ unsigned xb_xcc_id() { return (unsigned)__builtin_amdgcn_s_getreg((3 << 11) | 20) & 0xFu; }
#define XB_SPIN(cond, bar) do { unsigned _sp = 0; while (cond) { __builtin_amdgcn_s_sleep(1); \
    if ((++_sp & 255u) == 0u) { if (xb_ld(&(bar)[XB_TMO])) break; if (_sp > XB_SPIN_CAP) { atomicAdd(&(bar)[XB_TMO], 1u); break; } } } } while (0)

struct XcdBarrier {
    unsigned* bar; unsigned x;
    volatile LAS unsigned* st;
};

__device__ __forceinline__ XcdBarrier xcd_barrier_post(unsigned* bar, volatile LAS unsigned* st) {
    XcdBarrier b; b.bar = bar; b.x = xb_xcc_id(); b.st = st;
    if (threadIdx.x == 0) (void)xb_add(&bar[XB_XCNT(b.x)], 1u);
    return b;
}
__device__ __forceinline__ void xcd_barrier_complete(unsigned* bar, unsigned x, unsigned& nloc, unsigned& nx) {
    const unsigned G = gridDim.x * gridDim.y * gridDim.z;
    unsigned sum, cnt, mine, sp = 0u;
    for (;;) {
        sum = 0u; cnt = 0u; mine = 0u;
#pragma unroll
        for (unsigned j = 0; j < 16; ++j) { const unsigned c = xb_ld(&bar[XB_XCNT(j)]); sum += c; cnt += (c > 0u) ? 1u : 0u; mine = (j == x) ? c : mine; }
        if (sum == G) break;
        __builtin_amdgcn_s_sleep(1);
        if ((++sp & 255u) == 0u) { if (xb_ld(&bar[XB_TMO])) break; if (sp > XB_SPIN_CAP) { atomicAdd(&bar[XB_TMO], 1u); break; } }
    }
    nloc = mine > 0u ? mine : 1u; nx = cnt > 0u ? cnt : 1u;
}

__device__ __forceinline__ void xcd_barrier(const XcdBarrier& b) {
    asm volatile("s_waitcnt vmcnt(0)" ::: "memory");
    __syncthreads();
    if (threadIdx.x == 0) {
        unsigned* bar = b.bar;
        __builtin_amdgcn_s_waitcnt(0);
        unsigned nloc = b.st[0], nx = b.st[1];
        if (nloc == 0u) { xcd_barrier_complete(bar, b.x, nloc, nx); b.st[0] = nloc; b.st[1] = nx; }
        const unsigned old = xb_add(&bar[XB_XSUB(b.x)], 1u);
        const unsigned gen = old / nloc;
        if (old + 1u == (gen + 1u) * nloc) {
            __builtin_amdgcn_fence(__ATOMIC_RELEASE, "agent");
            asm volatile("s_waitcnt vmcnt(0)" ::: "memory");
            const unsigned og = xb_add(&bar[XB_TOP], 1u);
            const unsigned tg = og / nx;
            if (og + 1u == (tg + 1u) * nx) xb_add(&bar[XB_TOPGEN], 1u);
            else XB_SPIN(xb_ld(&bar[XB_TOPGEN]) == tg, bar);
            __builtin_amdgcn_fence(__ATOMIC_ACQUIRE, "agent");
            xb_add(&bar[XB_XGEN(b.x)], 1u);
            asm volatile("s_waitcnt vmcnt(0)" ::: "memory");
        } else {
            XB_SPIN(xb_ld(&bar[XB_XGEN(b.x)]) == gen, bar);
            __builtin_amdgcn_fence(__ATOMIC_ACQUIRE, "agent");
            asm volatile("s_waitcnt vmcnt(0)" ::: "memory");
        }
    }
    __syncthreads();
}


__device__ __forceinline__ void unpack8(const u32x4 w, float (&v)[8]);
namespace pg8 {
constexpr int BM = 256, BK = 64, HALF = 128, HTB = HALF * BK * 2, STAGE_BYTES = 8 * HTB, NXCD = 8, WGM = 8;
__device__ __forceinline__ int lds_byte(int r, int c) { const int st = (r >> 4) * 2 + (c >> 5), rr = r & 15, cc = c & 31, ob = rr * 64 + cc * 2; return st * 1024 + (ob ^ (((ob >> 9) & 1) << 5)); }
__device__ __forceinline__ void stage_rc(int b, int& R, int& C) { const int st = b / 1024, sb = b % 1024, swz = sb ^ (((sb >> 9) & 1) << 5); R = (st >> 1) * 16 + swz / 64; C = (st & 1) * 32 + (swz % 64) / 2; }
__device__ __forceinline__ int perm32(int rho) { const int n = rho >> 4, i = rho & 15; return 8 * (i >> 2) + 4 * n + (i & 3); }
struct Unit { int pm, pn, z, row0; const char* A; const char* B; };
__device__ __forceinline__ int tile_row0(int pm) { return (pm >> 3) * TP + 64 + (pm & 7) * 256; }
__device__ __forceinline__ void tile_of(int wgid, int nM, int nN, int& pm, int& pn) {
    const int nwg = nM * nN; { const int q = nwg / NXCD, r = nwg % NXCD, xcd = wgid % NXCD, off = wgid / NXCD; wgid = (xcd < r ? xcd * (q + 1) : r * (q + 1) + (xcd - r) * q) + off; }
    const int nig = WGM * nN, gid = wgid / nig, fm = gid * WGM, gsz = (nM - fm) < WGM ? (nM - fm) : WGM;
    pm = fm + ((wgid % nig) % gsz); pn = (wgid % nig) / gsz;
}
struct PlainOrder {
    const char* A; const char* B; int lda, ldb, nM, nN, G, c;
    __device__ __forceinline__ bool next(int i, Unit& u) const {
        const long L = (long)i * G + c; if (L >= (long)nM * nN) return false;
        tile_of((int)L, nM, nN, u.pm, u.pn); u.z = 0;
        u.row0 = tile_row0(u.pm); u.A = A + (size_t)u.row0 * lda * 2; u.B = B + (size_t)u.pn * 256 * ldb * 2; return true;
    }
};
struct MergeOrder {
    const char* A; const char* B; int nM, nN, G, c;
    __device__ __forceinline__ bool next(int i, Unit& u) const {
        const long L = (long)(i >> 2) * G + c; if (L >= (long)nM * nN) return false;
        tile_of((int)L, nM, nN, u.pm, u.pn); u.z = i & 3;
        u.row0 = tile_row0(u.pm); u.A = A + ((size_t)u.row0 * LDBR + (size_t)u.z * 512) * 2; u.B = B + ((size_t)u.z * 1024 * 512 + (size_t)u.pn * 256 * 512) * 2; return true;
    }
};
__device__ __forceinline__ unsigned cvt_pk_bf16(float lo, float hi) { return pk2(lo, hi); }

struct EpiF32 {
    static constexpr bool PERM = false, RMW = false, CHAIN = false;
    float* C; int ldc;
    __device__ __forceinline__ void operator()(const f32x4 (&acc)[2][2][4][2], const Unit& u, int wr, int wc, int fr, int fq) const {
        const int row0 = u.row0 + wr * 64 + fr, col0 = u.pn * BM + wc * 32 + 4 * fq;
#pragma unroll
        for (int ai = 0; ai < 2; ++ai)
#pragma unroll
            for (int m = 0; m < 4; ++m) { float* rowp = C + (size_t)(row0 + ai * HALF + m * 16) * ldc + col0;
#pragma unroll
                for (int bj = 0; bj < 2; ++bj)
#pragma unroll
                    for (int n = 0; n < 2; ++n) *(f32x4*)(rowp + bj * HALF + n * 16) = acc[ai][bj][m][n]; }
    }
};
struct EpiProj {
    static constexpr bool PERM = true, RMW = false, CHAIN = false;
    unsigned char* ws;
    __device__ __forceinline__ void operator()(const f32x4 (&acc)[2][2][4][2], const Unit& u, int wr, int wc, int fr, int fq) const {
        bf16_t* const MX = (bf16_t*)(ws + WS_MX); unsigned char* const G = ws + WS_G; bf16_t* const DT = (bf16_t*)(ws + WS_DT);
        bf16_t* base; int ldc, colt;
        const bool isg = u.pn >= 22 && u.pn < 38;
        if (u.pn < 22) { base = MX; ldc = LDMX; colt = u.pn * 256; } else { base = DT; ldc = LDDT; colt = isg ? (u.pn - 22) * 256 : 0; }
        const int row0 = u.row0 + wr * 64 + fr, col0 = colt + wc * 32 + 8 * fq;
        if (isg) {
            unsigned char* G8 = G;
#pragma unroll
            for (int ai = 0; ai < 2; ++ai)
#pragma unroll
                for (int m = 0; m < 4; ++m) { unsigned char* rowp = G8 + (size_t)(row0 + ai * HALF + m * 16) * LDG + col0;
#pragma unroll
                    for (int bj = 0; bj < 2; ++bj) { const f32x4 v0 = acc[ai][bj][m][0], v1 = acc[ai][bj][m][1];
                        *(u32x2*)(rowp + bj * HALF) = (u32x2){gate_q8x4(v0[0], v0[1], v0[2], v0[3]), gate_q8x4(v1[0], v1[1], v1[2], v1[3])}; } }
        } else {
        const bool sil = u.pn == 4 || u.pn == 5 || u.pn == 8 || u.pn == 9 || u.pn == 14 || u.pn == 15 || u.pn == 20 || u.pn == 21;
#pragma unroll
        for (int ai = 0; ai < 2; ++ai)
#pragma unroll
            for (int m = 0; m < 4; ++m) { bf16_t* rowp = base + (size_t)(row0 + ai * HALF + m * 16) * ldc + col0;
#pragma unroll
                for (int bj = 0; bj < 2; ++bj) { f32x4 v0 = acc[ai][bj][m][0], v1 = acc[ai][bj][m][1];
                    if (sil) {
#pragma unroll
                        for (int j = 0; j < 4; ++j) { v0[j] = siluf_(v0[j]); v1[j] = siluf_(v1[j]); } }
                    u32x4 w; w.x = cvt_pk_bf16(v0[0], v0[1]); w.y = cvt_pk_bf16(v0[2], v0[3]); w.z = cvt_pk_bf16(v1[0], v1[1]); w.w = cvt_pk_bf16(v1[2], v1[3]);
                    *(u32x4*)(rowp + bj * HALF) = w; } }
        }
    }
};
struct EpiBf {
    static constexpr bool PERM = true, RMW = false, CHAIN = false;
    bf16_t* O; int ldc;
    __device__ __forceinline__ void operator()(const f32x4 (&acc)[2][2][4][2], const Unit& u, int wr, int wc, int fr, int fq) const {
        const int row0 = u.row0 + wr * 64 + fr, col0 = u.pn * BM + wc * 32 + 8 * fq;
#pragma unroll
        for (int ai = 0; ai < 2; ++ai)
#pragma unroll
            for (int m = 0; m < 4; ++m) { bf16_t* rowp = O + (size_t)(row0 + ai * HALF + m * 16) * ldc + col0;
#pragma unroll
                for (int bj = 0; bj < 2; ++bj) { const f32x4 v0 = acc[ai][bj][m][0], v1 = acc[ai][bj][m][1];
                    u32x4 w; w.x = cvt_pk_bf16(v0[0], v0[1]); w.y = cvt_pk_bf16(v0[2], v0[3]); w.z = cvt_pk_bf16(v1[0], v1[1]); w.w = cvt_pk_bf16(v1[2], v1[3]);
                    *(u32x4*)(rowp + bj * HALF) = w; } }
    }
};
struct EpiUp {
    static constexpr bool PERM = true, RMW = false, CHAIN = false;
    bf16_t* O; int ldc;
    __device__ __forceinline__ void operator()(const f32x4 (&acc)[2][2][4][2], const Unit& u, int wr, int wc, int fr, int fq) const {
        const int row0 = u.row0 + wr * 64 + fr, col0 = u.pn * BM + wc * 32 + 8 * fq;
#pragma unroll
        for (int ai = 0; ai < 2; ++ai)
#pragma unroll
            for (int m = 0; m < 4; ++m) { bf16_t* rowp = O + (size_t)(row0 + ai * HALF + m * 16) * ldc + col0;
#pragma unroll
                for (int bj = 0; bj < 2; ++bj) { f32x4 v0 = acc[ai][bj][m][0], v1 = acc[ai][bj][m][1];
#pragma unroll
                    for (int j = 0; j < 4; ++j) { const float a = fmaxf(v0[j], 0.f), b = fmaxf(v1[j], 0.f); v0[j] = a * a; v1[j] = b * b; }
                    u32x4 w; w.x = cvt_pk_bf16(v0[0], v0[1]); w.y = cvt_pk_bf16(v0[2], v0[3]); w.z = cvt_pk_bf16(v1[0], v1[1]); w.w = cvt_pk_bf16(v1[2], v1[3]);
                    *(u32x4*)(rowp + bj * HALF) = w; } }
    }
};
struct EpiGlu {
    static constexpr bool PERM = true, RMW = false, CHAIN = false;
    bf16_t* BR; const float* bias;
    __device__ __forceinline__ void operator()(const f32x4 (&acc)[2][2][4][2], const Unit& u, int wr, int wc, int fr, int fq) const {
        const int row0 = u.row0 + wr * 64 + fr, oc = u.pn * 128 + wc * 32 + 8 * fq;
        const f32x4 ba0 = *(const f32x4*)(bias + oc), ba1 = *(const f32x4*)(bias + oc + 4), bg0 = *(const f32x4*)(bias + 512 + oc), bg1 = *(const f32x4*)(bias + 512 + oc + 4);
#pragma unroll
        for (int ai = 0; ai < 2; ++ai)
#pragma unroll
            for (int m = 0; m < 4; ++m) { bf16_t* rowp = BR + (size_t)(row0 + ai * HALF + m * 16) * LDBR + 512 + oc;
                f32x4 a0 = acc[ai][0][m][0] + ba0, a1 = acc[ai][0][m][1] + ba1; const f32x4 g0 = acc[ai][1][m][0] + bg0, g1 = acc[ai][1][m][1] + bg1;
#pragma unroll
                for (int j = 0; j < 4; ++j) { a0[j] = a0[j] * sigmoidf_(g0[j]); a1[j] = a1[j] * sigmoidf_(g1[j]); }
                u32x4 w; w.x = cvt_pk_bf16(a0[0], a0[1]); w.y = cvt_pk_bf16(a0[2], a0[3]); w.z = cvt_pk_bf16(a1[0], a1[1]); w.w = cvt_pk_bf16(a1[2], a1[3]);
                *(u32x4*)rowp = w; }
    }
};
struct EpiMerge {
    static constexpr bool PERM = true, RMW = true, CHAIN = true;
    bf16_t* O; const bf16_t* G;
    __device__ __forceinline__ void operator()(f32x4 (&acc)[2][2][4][2], const Unit& u, int wr, int wc, int fr, int fq) const {
        const int row0 = u.row0 + wr * 64 + fr, col0 = u.pn * BM + wc * 32 + 8 * fq;
        const unsigned char* G8 = (const unsigned char*)G;
        if (u.z < 3) {
#pragma unroll
            for (int ai = 0; ai < 2; ++ai)
#pragma unroll
                for (int m = 0; m < 4; ++m) { const size_t row = (size_t)(row0 + ai * HALF + m * 16);
#pragma unroll
                    for (int bj = 0; bj < 2; ++bj) { const int col = col0 + bj * HALF;
                        const u32x2 ga = *(const u32x2*)(G8 + row * LDG + u.z * 1024 + col), gb = *(const u32x2*)(G8 + row * LDG + (u.z + 1) * 1024 + col);
                        { f32x4 r0, r1;
                          r0[0] = gate_s(ga.x, 0) * __builtin_amdgcn_rcpf(gate_s(gb.x, 0)); r0[1] = gate_s(ga.x, 1) * __builtin_amdgcn_rcpf(gate_s(gb.x, 1)); r0[2] = gate_s(ga.x, 2) * __builtin_amdgcn_rcpf(gate_s(gb.x, 2)); r0[3] = gate_s(ga.x, 3) * __builtin_amdgcn_rcpf(gate_s(gb.x, 3));
                          r1[0] = gate_s(ga.y, 0) * __builtin_amdgcn_rcpf(gate_s(gb.y, 0)); r1[1] = gate_s(ga.y, 1) * __builtin_amdgcn_rcpf(gate_s(gb.y, 1)); r1[2] = gate_s(ga.y, 2) * __builtin_amdgcn_rcpf(gate_s(gb.y, 2)); r1[3] = gate_s(ga.y, 3) * __builtin_amdgcn_rcpf(gate_s(gb.y, 3));
                          acc[ai][bj][m][0] = acc[ai][bj][m][0] * r0; acc[ai][bj][m][1] = acc[ai][bj][m][1] * r1; } } }
        } else {
#pragma unroll
            for (int ai = 0; ai < 2; ++ai)
#pragma unroll
                for (int m = 0; m < 4; ++m) { const size_t row = (size_t)(row0 + ai * HALF + m * 16);
#pragma unroll
                    for (int bj = 0; bj < 2; ++bj) { const int col = col0 + bj * HALF;
                        const u32x2 gw = *(const u32x2*)(G8 + row * LDG + 3 * 1024 + col);
                        f32x4 v0 = acc[ai][bj][m][0], v1 = acc[ai][bj][m][1];
                        v0 = v0 * (f32x4){gate_s(gw.x, 0), gate_s(gw.x, 1), gate_s(gw.x, 2), gate_s(gw.x, 3)} * (1.f / 256.f); v1 = v1 * (f32x4){gate_s(gw.y, 0), gate_s(gw.y, 1), gate_s(gw.y, 2), gate_s(gw.y, 3)} * (1.f / 256.f);
                        u32x4 w; w.x = cvt_pk_bf16(v0[0], v0[1]); w.y = cvt_pk_bf16(v0[2], v0[3]); w.z = cvt_pk_bf16(v1[0], v1[1]); w.w = cvt_pk_bf16(v1[2], v1[3]);
                        *(u32x4*)(O + row * 1024 + col) = w; } }
        }
    }
};

template <class Epi, class Sched>
__device__ __forceinline__ void gemm_phase(LAS unsigned char* lds, const int lda, const int ldb, const int K, const Sched& S, const Epi& E) {
    int tid_ = threadIdx.x; asm volatile("" : "+v"(tid_));
    const int tid = tid_, wid = __builtin_amdgcn_readfirstlane(tid >> 6), lane = tid & 63, wr = wid >> 2, wc = wid & 3, fr = lane & 15, fq = lane >> 4;
    const int nt = K / BK;
    unsigned voffA[2], voffB[2];
#pragma unroll
    for (int i = 0; i < 2; ++i) { int R, C; stage_rc(tid * 16 + i * 8192, R, C); const int Rb = Epi::PERM ? ((R & ~31) + perm32(R & 31)) : R;
        voffA[i] = (unsigned)(R * lda + C) * 2u; voffB[i] = (unsigned)(Rb * ldb + C) * 2u; }
    const size_t kstep = (size_t)(BK * 2);
    const size_t hstepA = (size_t)HALF * lda * 2, hstepB = (size_t)HALF * ldb * 2;
    const unsigned ldsw = (unsigned)wid * 1024u;
    const int aoff = lds_byte(wr * 64 + fr, fq * 8), boff = lds_byte(wc * 32 + fr, fq * 8);
#define PG8_SA(b, h) (((b) * 2 + (h)) * HTB)
#define PG8_SB(b, h) ((4 + (b) * 2 + (h)) * HTB)
#define PG8_STAGE(bufoff, gbase, voff) do { _Pragma("unroll") for (int _i = 0; _i < 2; ++_i) \
        __builtin_amdgcn_global_load_lds((const unsigned*)((const char*)(gbase) + (voff)[_i]), (LAS unsigned*)(lds + (bufoff) + ldsw + _i * 8192), 16, 0, 0); } while (0)
#define PG8_LDA(dst, b, h) do { _Pragma("unroll") for (int m = 0; m < 4; ++m) _Pragma("unroll") for (int k = 0; k < 2; ++k) dst[m][k] = *(const LAS bf16x8*)(lds + PG8_SA(b, h) + aoff + m * 2048 + k * 1024); } while (0)
#define PG8_LDB(dst, b, h) do { _Pragma("unroll") for (int n = 0; n < 2; ++n) _Pragma("unroll") for (int k = 0; k < 2; ++k) dst[n][k] = *(const LAS bf16x8*)(lds + PG8_SB(b, h) + boff + n * 2048 + k * 1024); } while (0)
#define PG8_MMA(ai, bj, At, Bt) do { __builtin_amdgcn_s_setprio(1); _Pragma("unroll") for (int m = 0; m < 4; ++m) _Pragma("unroll") for (int n = 0; n < 2; ++n) _Pragma("unroll") for (int k = 0; k < 2; ++k) \
        acc[ai][bj][m][n] = __builtin_amdgcn_mfma_f32_16x16x32_bf16(Bt[n][k], At[m][k], acc[ai][bj][m][n], 0, 0, 0); __builtin_amdgcn_s_setprio(0); } while (0)
#define PG8_WAIT_V(n) asm volatile("s_waitcnt vmcnt(" #n ")" ::: "memory")
#define PG8_WAIT_L(n) asm volatile("s_waitcnt lgkmcnt(" #n ")" ::: "memory")
#define PG8_BAR __builtin_amdgcn_s_barrier()
#define PG8_SCHED __builtin_amdgcn_sched_barrier(0)
    Unit cur, nxt; int ui = 0;
    if (!S.next(0, cur)) return;
    f32x4 acc[2][2][4][2];
#pragma unroll
    for (int a = 0; a < 2; ++a)
#pragma unroll
        for (int b = 0; b < 2; ++b)
#pragma unroll
            for (int m = 0; m < 4; ++m)
#pragma unroll
                for (int n = 0; n < 2; ++n) acc[a][b][m][n] = (f32x4){0.f, 0.f, 0.f, 0.f};
    bf16x8 At[4][2], B0[2][2], B1[2][2];
    const char* cA = cur.A; const char* cB = cur.B;
    PG8_STAGE(PG8_SB(0, 0), cB, voffB); PG8_STAGE(PG8_SB(0, 1), cB + hstepB, voffB); PG8_STAGE(PG8_SA(0, 0), cA, voffA); PG8_STAGE(PG8_SA(0, 1), cA + hstepA, voffA);
    if (wr == 1) PG8_BAR;
    PG8_WAIT_V(2); PG8_BAR;
    PG8_STAGE(PG8_SB(1, 0), cB + kstep, voffB); PG8_STAGE(PG8_SA(1, 0), cA + kstep, voffA); PG8_STAGE(PG8_SB(1, 1), cB + hstepB + kstep, voffB);
    PG8_WAIT_V(6); PG8_BAR;
    for (;;) {
        const bool has_next = S.next(ui + 1, nxt);
        const char* nA = has_next ? nxt.A : cA; const char* nB = has_next ? nxt.B : cB;
        for (int t = 0; t < nt; t += 2) {
            const bool last = (t == nt - 2);
            const char* a1 = cA + (size_t)(t + 1) * kstep;
            const char* a2 = last ? nA : cA + (size_t)(t + 2) * kstep; const char* b2 = last ? nB : cB + (size_t)(t + 2) * kstep;
            const char* a3 = a2 + kstep; const char* b3 = b2 + kstep;
            PG8_LDB(B0, 0, 0); PG8_LDB(B1, 0, 1); PG8_SCHED; PG8_LDA(At, 0, 0); PG8_STAGE(PG8_SA(1, 1), a1 + hstepA, voffA);
            PG8_WAIT_V(8); PG8_WAIT_L(0); PG8_BAR; PG8_MMA(0, 0, At, B0); PG8_MMA(0, 1, At, B1); PG8_BAR; PG8_SCHED;
            PG8_LDA(At, 0, 1); PG8_STAGE(PG8_SB(0, 0), b2, voffB); PG8_STAGE(PG8_SB(0, 1), b2 + hstepB, voffB); PG8_STAGE(PG8_SA(0, 0), a2, voffA);
            PG8_WAIT_V(8); PG8_WAIT_L(0); PG8_BAR; PG8_MMA(1, 0, At, B0); PG8_MMA(1, 1, At, B1); PG8_BAR; PG8_SCHED;
            PG8_LDB(B0, 1, 0); PG8_LDB(B1, 1, 1); PG8_SCHED; PG8_LDA(At, 1, 0); PG8_STAGE(PG8_SA(0, 1), a2 + hstepA, voffA);
            PG8_WAIT_V(8); PG8_WAIT_L(0); PG8_BAR; PG8_MMA(0, 0, At, B0); PG8_MMA(0, 1, At, B1); PG8_BAR; PG8_SCHED;
            PG8_LDA(At, 1, 1); PG8_STAGE(PG8_SB(1, 0), b3, voffB); PG8_STAGE(PG8_SB(1, 1), b3 + hstepB, voffB); PG8_STAGE(PG8_SA(1, 0), a3, voffA);
            PG8_WAIT_V(8); PG8_WAIT_L(0); PG8_BAR; PG8_MMA(1, 0, At, B0); PG8_MMA(1, 1, At, B1); PG8_BAR; PG8_SCHED;
        }
        if (wr == 0) PG8_BAR;
        E(acc, cur, wr, wc, fr, fq);
        if (EPIREP && !Epi::RMW) { asm volatile("" ::: "memory"); E(acc, cur, wr, wc, fr, fq); }
        if (!has_next) break;
        if (!(Epi::CHAIN && cur.z < 3)) {
#pragma unroll
        for (int a = 0; a < 2; ++a)
#pragma unroll
            for (int b = 0; b < 2; ++b)
#pragma unroll
                for (int m = 0; m < 4; ++m)
#pragma unroll
                    for (int n = 0; n < 2; ++n) acc[a][b][m][n] = (f32x4){0.f, 0.f, 0.f, 0.f};
        }
        cur = nxt; cA = nA; cB = nB; ++ui;
        if (wr == 1) PG8_BAR;
    }
    PG8_WAIT_V(0);
    PG8_BAR;
#undef PG8_SA
#undef PG8_SB
#undef PG8_STAGE
#undef PG8_LDA
#undef PG8_LDB
#undef PG8_MMA
#undef PG8_WAIT_V
#undef PG8_WAIT_L
#undef PG8_BAR
#undef PG8_SCHED
}
}

template <int MODE> __device__ __forceinline__ int colmap(int n) {
    if (MODE == 1) { if (n < 3584) return n; if (n < 9728) return n + 8; if (n < 9736) return 3584 + (n - 9728); return -1; }
    if (MODE == 2) { const int pn = n >> 8, bj = (n >> 7) & 1, i = n & 127; return bj * 512 + pn * 128 + i; }
    return n;
}
struct TrItem { const float* W; bf16_t* WT; int K, Nsrc, mode, k0, n0; };
__device__ __forceinline__ int colmap_rt(int mode, int n) { return mode == 1 ? colmap<1>(n) : (mode == 2 ? colmap<2>(n) : n); }
__device__ __forceinline__ TrItem tr_decode(const Params& p, int l, int it) {
    constexpr int I_IN = 16 * (NPROJ / 32), I_BR1 = 8 * 32, I_OUT = 16 * 32, I_UP = 16 * 128, I_DN = 64 * 32;
    TrItem t; int r = it, Ndst;
    if (r < I_IN) { t.W = p.in[2] + (size_t)l * 1024 * 9736; t.WT = (bf16_t*)(p.ws + WS_WIN); t.K = 1024; t.Nsrc = 9736; Ndst = NPROJ; t.mode = 1; }
    else if ((r -= I_IN) < 4 * I_BR1) { const int n = r / I_BR1; r -= n * I_BR1; t.W = p.in[3] + ((size_t)l * 4 + n) * 512 * 1024; t.WT = (bf16_t*)(p.ws + WS_WBR) + (size_t)n * 1024 * 512; t.K = 512; t.Nsrc = 1024; Ndst = 1024; t.mode = 0; }
    else if ((r -= 4 * I_BR1) < I_OUT) { t.W = p.in[4] + (size_t)l * 1024 * 1024; t.WT = (bf16_t*)(p.ws + WS_WOUT); t.K = 1024; t.Nsrc = 1024; Ndst = 1024; t.mode = 0; }
    else if ((r -= I_OUT) < I_UP) { t.W = p.in[9] + (size_t)l * 1024 * 4096; t.WT = (bf16_t*)(p.ws + WS_WUP); t.K = 1024; t.Nsrc = 4096; Ndst = 4096; t.mode = 0; }
    else if ((r -= I_UP) < I_DN) { t.W = p.in[10] + (size_t)l * 4096 * 1024; t.WT = (bf16_t*)(p.ws + WS_WDN); t.K = 4096; t.Nsrc = 1024; Ndst = 1024; t.mode = 0; }
    else { r -= I_DN; t.W = p.in[20] + (size_t)l * 512 * 1024; t.WT = (bf16_t*)(p.ws + WS_WGLU); t.K = 512; t.Nsrc = 1024; Ndst = 1024; t.mode = 2; }
    const int nblk = Ndst / 32, kb = r / nblk, nb = r - kb * nblk; t.k0 = 64 * kb; t.n0 = 32 * nb;
    return t;
}
__device__ __forceinline__ void tr_load(const TrItem& t, int lane, float (&v)[32]) {
    const int sc = colmap_rt(t.mode, t.n0 + (lane & 31));
    const float* src = t.W + (size_t)(t.k0 + (lane >> 5)) * t.Nsrc + (sc >= 0 ? sc : 0);
#pragma unroll
    for (int i = 0; i < 32; ++i) { const float x = src[(size_t)(2 * i) * t.Nsrc]; v[i] = sc >= 0 ? x : 0.f; }
}
__device__ __forceinline__ void convert_layer(const Params& p, int l, LAS unsigned char* lds) {
    const int tid__ = opaque_tid(); const int lane = tid__ & 63, wave = tid__ >> 6;
    LAS float* scr = (LAS float*)(lds + wave * 8448);
    const int gw = blockIdx.x * 8 + wave, NGW = gridDim.x * 8;
    constexpr int NIT = 16 * (NPROJ / 32) + 4 * 8 * 32 + 16 * 32 + 16 * 128 + 64 * 32 + 8 * 32;
    float v[32]; TrItem cur{};
    int it = gw;
    if (it < NIT) { cur = tr_decode(p, l, it); tr_load(cur, lane, v); }
    while (it < NIT) {
        const TrItem done = cur;
#pragma unroll
        for (int i = 0; i < 32; ++i) scr[(2 * i + (lane >> 5)) * 33 + (lane & 31)] = v[i];
        const int nxt = it + NGW;
        if (nxt < NIT) { cur = tr_decode(p, l, nxt); tr_load(cur, lane, v); }
        LDS_WAIT();
        const int c = lane & 7;
#pragma unroll
        for (int j = 0; j < 4; ++j) { const int n = (lane >> 3) + 8 * j; const LAS float* sp = scr + (8 * c) * 33 + n;
            u32x4 o; o.x = pk2(sp[0 * 33], sp[1 * 33]); o.y = pk2(sp[2 * 33], sp[3 * 33]); o.z = pk2(sp[4 * 33], sp[5 * 33]); o.w = pk2(sp[6 * 33], sp[7 * 33]);
            *(u32x4*)(done.WT + (size_t)(done.n0 + n) * done.K + done.k0 + 8 * c) = o; }
        LDS_WAIT();
        it = nxt;
    }
}

template <int MODE, bool FINAL> __device__ __forceinline__ void norm_phase(const Params& p, const float* wpost, const float* wpre) {
    const int tid__ = opaque_tid(); const int lane = tid__ & 63, wave = tid__ >> 6;
    const int gw = blockIdx.x * 8 + wave, NGW = gridDim.x * 8;
    float* H = (float*)(p.ws + WS_H); const bf16_t* DL = (const bf16_t*)(p.ws + WS_DELTA); bf16_t* U = (bf16_t*)(p.ws + WS_U);
    f32x4 hn[4]; u32x2 dn[4];
    auto src_of = [&](int row) -> const float* { const int b = row / TP, r = row - b * TP;
        if (MODE == 0) return r < 64 ? p.in[1] + (size_t)(r < PADF ? 0 : r - PADF) * 1024 : p.in[0] + ((size_t)b * SEQ + (r - 64)) * 1024;
        return H + (size_t)row * 1024; };
    auto load_row = [&](int row) { const float* src = src_of(row);
#pragma unroll
        for (int j = 0; j < 4; ++j) { hn[j] = *(const f32x4*)(src + 4 * lane + 256 * j); if (MODE == 1) dn[j] = *(const u32x2*)(DL + (size_t)row * 1024 + 4 * lane + 256 * j); } };
    if (gw < MROWS) load_row(gw);
    for (int row = gw; row < MROWS; row += NGW) {
        const int b = row / TP, r = row - b * TP; const bool pad = r < PADF;
        f32x4 hv[4], dv[4];
#pragma unroll
        for (int j = 0; j < 4; ++j) { hv[j] = hn[j]; if (MODE == 1) dv[j] = (f32x4){bflo(dn[j].x), bfhi(dn[j].x), bflo(dn[j].y), bfhi(dn[j].y)}; }
        if (row + NGW < MROWS) load_row(row + NGW);
        if (MODE == 0) {
#pragma unroll
            for (int j = 0; j < 4; ++j) if (pad) hv[j] = (f32x4){0.f, 0.f, 0.f, 0.f};
        } else {
            float ss = 0.f;
#pragma unroll
            for (int j = 0; j < 4; ++j) ss += (dv[j][0] * dv[j][0] + dv[j][1] * dv[j][1]) + (dv[j][2] * dv[j][2] + dv[j][3] * dv[j][3]);
            const float rstd = rsqrtf(wave_sum(ss) * (1.f / 1024.f) + EPS);
#pragma unroll
            for (int j = 0; j < 4; ++j) { const f32x4 w = *(const f32x4*)(wpost + 4 * lane + 256 * j); hv[j] = hv[j] + dv[j] * rstd * w; if (pad) hv[j] = (f32x4){0.f, 0.f, 0.f, 0.f}; }
        }
        if (FINAL) {
            if (r >= 64) {
#pragma unroll
                for (int j = 0; j < 4; ++j) *(f32x4*)(p.out + ((size_t)b * SEQ + (r - 64)) * 1024 + 4 * lane + 256 * j) = hv[j];
            }
        } else {
            float ss = 0.f;
#pragma unroll
            for (int j = 0; j < 4; ++j) { *(f32x4*)(H + (size_t)row * 1024 + 4 * lane + 256 * j) = hv[j]; ss += (hv[j][0] * hv[j][0] + hv[j][1] * hv[j][1]) + (hv[j][2] * hv[j][2] + hv[j][3] * hv[j][3]); }
            const float rstd = rsqrtf(wave_sum(ss) * (1.f / 1024.f) + EPS);
#pragma unroll
            for (int j = 0; j < 4; ++j) { const f32x4 w = *(const f32x4*)(wpre + 4 * lane + 256 * j); const f32x4 o = hv[j] * rstd * w;
                u32x2 q; q.x = pk2(o[0], o[1]); q.y = pk2(o[2], o[3]); *(u32x2*)(U + (size_t)row * 1024 + 4 * lane + 256 * j) = q; }
        }
    }
}

__device__ __forceinline__ void unpack8(const u32x4 w, float (&v)[8]) { v[0] = bflo(w.x); v[1] = bfhi(w.x); v[2] = bflo(w.y); v[3] = bfhi(w.y); v[4] = bflo(w.z); v[5] = bfhi(w.z); v[6] = bflo(w.w); v[7] = bfhi(w.w); }
__device__ __forceinline__ u32x4 pack8(const float (&v)[8]) { u32x4 w; w.x = pk2(v[0], v[1]); w.y = pk2(v[2], v[3]); w.z = pk2(v[4], v[5]); w.w = pk2(v[6], v[7]); return w; }
__device__ __forceinline__ void post_phase(const Params& p, int l) {
    const int tid__ = opaque_tid(); const int lane = tid__ & 63, wave = tid__ >> 6;
    const int gw = blockIdx.x * 8 + wave, NGW = gridDim.x * 8;
    bf16_t* BR = (bf16_t*)(p.ws + WS_BR); const bf16_t* MX = (const bf16_t*)(p.ws + WS_MX);
    const float* gnw = p.in[11] + l * 512 + lane * 8; const float* ssdw = p.in[27] + l * 512 + lane * 8; const float* hgw = p.in[29] + l * 512 + lane * 8;
    u32x4 n0, n1, n2, n3, n4;
    auto load_row = [&](int row) { const bf16_t* br = BR + (size_t)row * LDBR + lane * 8; const bf16_t* mx = MX + (size_t)row * LDMX + lane * 8;
        n0 = *(const u32x4*)br; n1 = *(const u32x4*)(mx + RG); n2 = *(const u32x4*)(br + 1024); n3 = *(const u32x4*)(br + 1536); n4 = *(const u32x4*)(mx + HGT); };
    if (gw < MROWS) load_row(gw);
    for (int row = gw; row < MROWS; row += NGW) {
        bf16_t* br = BR + (size_t)row * LDBR + lane * 8;
        const u32x4 c0 = n0, c1 = n1, c2 = n2, c3 = n3, c4 = n4;
        if (row + NGW < MROWS) load_row(row + NGW);
        float y[8], g[8];
        {
            unpack8(c0, y); unpack8(c1, g);
            float s = 0.f;
#pragma unroll
            for (int j = 0; j < 8; ++j) s += y[j];
            s += __shfl_xor(s, 1); s += __shfl_xor(s, 2); s += __shfl_xor(s, 4); s += __shfl_xor(s, 8);
            const float mu = s * (1.f / 128.f); float v = 0.f;
#pragma unroll
            for (int j = 0; j < 8; ++j) { y[j] -= mu; v += y[j] * y[j]; }
            v += __shfl_xor(v, 1); v += __shfl_xor(v, 2); v += __shfl_xor(v, 4); v += __shfl_xor(v, 8);
            const float rstd = rsqrtf(v * (1.f / 128.f) + EPS);
#pragma unroll
            for (int j = 0; j < 8; ++j) y[j] = g[j] * (y[j] * rstd * gnw[j]);
            *(u32x4*)br = pack8(y);
        }
        {
            unpack8(c2, y);
            float v = 0.f;
#pragma unroll
            for (int j = 0; j < 8; ++j) v += y[j] * y[j];
            v += __shfl_xor(v, 1); v += __shfl_xor(v, 2); v += __shfl_xor(v, 4); v += __shfl_xor(v, 8); v += __shfl_xor(v, 16);
            const float rstd = rsqrtf(v * (1.f / 256.f) + EPS);
#pragma unroll
            for (int j = 0; j < 8; ++j) y[j] = y[j] * rstd * ssdw[j];
            *(u32x4*)(br + 1024) = pack8(y);
        }
        {
            unpack8(c3, y); unpack8(c4, g);
            float v = 0.f;
#pragma unroll
            for (int j = 0; j < 8; ++j) v += y[j] * y[j];
            v += __shfl_xor(v, 1); v += __shfl_xor(v, 2); v += __shfl_xor(v, 4); v += __shfl_xor(v, 8);
            const float rstd = rsqrtf(v * (1.f / 128.f) + EPS);
#pragma unroll
            for (int j = 0; j < 8; ++j) y[j] = y[j] * rstd * hgw[j] * g[j];
            *(u32x4*)(br + 1536) = pack8(y);
        }
    }
}

__device__ __forceinline__ void conv_phase(const Params& p, int l) {
    const int tid = opaque_tid();
    const bf16_t* MX = (const bf16_t*)(p.ws + WS_MX); bf16_t* XBC = (bf16_t*)(p.ws + WS_XBC);
    const int NT = NB * (TP / 8) * 128;
    for (int task = blockIdx.x * 512 + tid; task < NT; task += gridDim.x * 512) {
        const int cg8 = task & 127, rb = (task >> 7) % (TP / 8), b = (task >> 7) / (TP / 8), ch0 = cg8 * 8, r0 = rb * 8;
        if (b > 0 && r0 < 64) continue;
        bf16_t* dst = XBC + ((size_t)b * TP + r0) * 1024 + ch0;
        if (r0 < PADF) {
#pragma unroll
            for (int i = 0; i < 8; ++i) *(u32x4*)(dst + (size_t)i * 1024) = (u32x4){0u, 0u, 0u, 0u};
            continue; }
        float cw[4][8], cb[8], win[3][8];
#pragma unroll
        for (int j = 0; j < 4; ++j) { const f32x4 x0 = *(const f32x4*)(p.in[22] + (size_t)(l * 4 + j) * 1024 + ch0), x1 = *(const f32x4*)(p.in[22] + (size_t)(l * 4 + j) * 1024 + ch0 + 4);
            cw[j][0] = x0[0]; cw[j][1] = x0[1]; cw[j][2] = x0[2]; cw[j][3] = x0[3]; cw[j][4] = x1[0]; cw[j][5] = x1[1]; cw[j][6] = x1[2]; cw[j][7] = x1[3]; }
        { const f32x4 x0 = *(const f32x4*)(p.in[23] + l * 1024 + ch0), x1 = *(const f32x4*)(p.in[23] + l * 1024 + ch0 + 4);
          cb[0] = x0[0]; cb[1] = x0[1]; cb[2] = x0[2]; cb[3] = x0[3]; cb[4] = x1[0]; cb[5] = x1[1]; cb[6] = x1[2]; cb[7] = x1[3]; }
        u32x4 raw[11];
#pragma unroll
        for (int k = 0; k < 11; ++k) { const int r = r0 - 3 + k; raw[k] = *(const u32x4*)(MX + (r < 64 ? (size_t)r : (size_t)b * TP + r) * LDMX + SXBC + ch0); }
#pragma unroll
        for (int k = 0; k < 3; ++k) unpack8(raw[k], win[k]);
#pragma unroll
        for (int i = 0; i < 8; ++i) { float cur[8], o[8]; unpack8(raw[3 + i], cur);
#pragma unroll
            for (int j = 0; j < 8; ++j) { o[j] = siluf_(cb[j] + cw[0][j] * win[0][j] + cw[1][j] * win[1][j] + cw[2][j] * win[2][j] + cw[3][j] * cur[j]); win[0][j] = win[1][j]; win[1][j] = win[2][j]; win[2][j] = cur[j]; }
            *(u32x4*)(dst + (size_t)i * 1024) = pack8(o); }
    }
}
__device__ __forceinline__ float hgrn_lb(const Params& p, int l, int ch) {
    const float* lb = p.in[28];
    const float v0 = lb[ch], v1 = lb[512 + ch], v2 = lb[1024 + ch], v3 = lb[1536 + ch];
    const float m = fmaxf(fmaxf(v0, v1), fmaxf(v2, v3));
    const float e0 = __expf(v0 - m), e1 = __expf(v1 - m), e2 = __expf(v2 - m), e3 = __expf(v3 - m);
    const float inv = 1.f / (e0 + e1 + e2 + e3);
    float acc = 0.f;
    if (l >= 1) acc += e1; if (l >= 2) acc += e2; if (l >= 3) acc += e3;
    return acc * inv;
}

__device__ __forceinline__ void s5_simple(const Params& p, int l, int unit) {
    const int lane = opaque_tid() & 63; const int b = unit >> 5, g = unit & 31;
    const bf16_t* MX = (const bf16_t*)(p.ws + WS_MX); bf16_t* S5P = (bf16_t*)(p.ws + WS_S5P);
    const int gp = (l * 32 + g) * 64 + lane;
    const float step = expf(p.in[19][l * 32 + g]), lr = p.in[12][gp], li = p.in[13][gp];
    const float mag = expf(lr * step); float sn, cs; sincos_turns(li * step * 0.15915494309f, sn, cs);
    const float ar = mag * cs, ai = mag * sn, inv = 1.f / (lr * lr + li * li);
    const float cor = ((ar - 1.f) * lr + ai * li) * inv, coi = (ai * lr - (ar - 1.f) * li) * inv;
    float bbr[16], bbi[16], cre[16], cim[16];
#pragma unroll
    for (int j = 0; j < 16; ++j) { const float br = p.in[14][(size_t)gp * 16 + j], bi = p.in[15][(size_t)gp * 16 + j]; bbr[j] = cor * br - coi * bi; bbi[j] = cor * bi + coi * br;
        cre[j] = p.in[16][((size_t)(l * 32 + g) * 16 + j) * 64 + lane]; cim[j] = p.in[17][((size_t)(l * 32 + g) * 16 + j) * 64 + lane]; }
    const float dsk = p.in[18][l * 512 + g * 16 + (lane & 15)];
    float xr = 0.f, xi = 0.f;
    for (int r = PADF; r < TP; ++r) {
        const size_t row = (size_t)b * TP + r;
        const float uv = bf2f(MX[row * LDMX + S5U + g * 16 + (lane & 15)]);
        float bur = 0.f, bui = 0.f;
#pragma unroll
        for (int j = 0; j < 16; ++j) { const float uj = __shfl(uv, j); bur += bbr[j] * uj; bui += bbi[j] * uj; }
        const float nxr = ar * xr - ai * xi + bur, nxi = ar * xi + ai * xr + bui; xr = nxr; xi = nxi;
        float yv = 0.f;
#pragma unroll
        for (int j = 0; j < 16; ++j) { const float s = wave_sum(xr * cre[j] - xi * cim[j]); yv = (lane == j) ? s : yv; }
        if (lane < 16) { const float y = yv + dsk * uv; S5P[row * 512 + g * 16 + lane] = (bf16_t)f2bf(geluf_(y)); }
    }
}
__device__ __forceinline__ void ret_simple(const Params& p, int l, int unit) {
    const int lane = opaque_tid() & 63; const int b = unit >> 3, hd = (unit >> 1) & 3, eh = unit & 1;
    const bf16_t* MX = (const bf16_t*)(p.ws + WS_MX); bf16_t* BR = (bf16_t*)(p.ws + WS_BR);
    const float gamma = 1.f - exp2f(-5.f - (float)hd);
    const int i = lane & 31; const float invf_t = exp2f(-(float)i * (13.287712379549449f / 32.f)) * 0.15915494309f;
    float h[64];
#pragma unroll
    for (int d = 0; d < 64; ++d) h[d] = 0.f;
    for (int r = PADF; r < TP; ++r) {
        const size_t row = (size_t)b * TP + r; const bf16_t* mx = MX + row * LDMX;
        float sn, cs; sincos_turns((float)(r - PADF) * invf_t, sn, cs);
        const float q1 = bf2f(mx[RQ + hd * 64 + i]), q2 = bf2f(mx[RQ + hd * 64 + 32 + i]), k1 = bf2f(mx[RK + hd * 64 + i]), k2 = bf2f(mx[RK + hd * 64 + 32 + i]);
        const float qr = lane < 32 ? q1 * cs - q2 * sn : q1 * sn + q2 * cs;
        const float kr = (lane < 32 ? k1 * cs - k2 * sn : k1 * sn + k2 * cs) * 0.125f;
        const float v = bf2f(mx[RV + hd * 128 + eh * 64 + lane]);
        float y = 0.f;
#pragma unroll
        for (int d = 0; d < 64; ++d) { const float kd = __shfl(kr, d), qd = __shfl(qr, d); h[d] = gamma * h[d] + kd * v; y += h[d] * qd; }
        BR[row * LDBR + hd * 128 + eh * 64 + lane] = (bf16_t)f2bf(y);
    }
}
__device__ __forceinline__ void ssd_simple(const Params& p, int l, int unit, LAS unsigned char* lds) {
    const int tid = opaque_tid(), lane = tid & 63, w = tid >> 6; const int b = unit >> 3, hd = unit & 7, g = hd >> 2;
    const bf16_t* MX = (const bf16_t*)(p.ws + WS_MX); bf16_t* BR = (bf16_t*)(p.ws + WS_BR); const bf16_t* DT = (const bf16_t*)(p.ws + WS_DT);
    LAS float* xs_s = (LAS float*)lds; LAS float* B_s = xs_s + 64; LAS float* C_s = B_s + 128; LAS float* dt_s = C_s + 128; LAS float* part = dt_s + 64;
    const float a = -expf(p.in[25][l * 8 + hd]), dtb = p.in[24][l * 8 + hd], Dh = p.in[26][l * 8 + hd];
    int ch = 0; float cw[4] = {0.f, 0.f, 0.f, 0.f}, cb = 0.f;
    if (tid < 320) { ch = tid < 64 ? hd * 64 + tid : (tid < 192 ? 512 + g * 128 + (tid - 64) : 768 + g * 128 + (tid - 192));
#pragma unroll
        for (int j = 0; j < 4; ++j) cw[j] = p.in[22][(size_t)(l * 4 + j) * 1024 + ch];
        cb = p.in[23][l * 1024 + ch]; }
    float h[16];
#pragma unroll
    for (int i = 0; i < 16; ++i) h[i] = 0.f;
    for (int r = PADF; r < TP; ++r) {
        const size_t row = (size_t)b * TP + r;
        if (tid < 320) { float o = cb;
#pragma unroll
            for (int j = 0; j < 4; ++j) o += cw[j] * bf2f(MX[(row - 3 + j) * LDMX + SXBC + ch]);
            o = siluf_(o); if (tid < 64) xs_s[tid] = o; else if (tid < 192) B_s[tid - 64] = o; else C_s[tid - 192] = o; }
        if (tid == 320) dt_s[0] = softplusf_(bf2f(DT[row * LDDT + hd]) + dtb);
        __syncthreads();
        const float dt = dt_s[0], da = __expf(dt * a), xv = xs_s[lane] * dt; float pt = 0.f;
#pragma unroll
        for (int i = 0; i < 16; ++i) { h[i] = da * h[i] + B_s[w * 16 + i] * xv; pt += h[i] * C_s[w * 16 + i]; }
        part[w * 64 + lane] = pt;
        __syncthreads();
        if (tid < 64) { float y = 0.f;
#pragma unroll
            for (int k = 0; k < 8; ++k) y += part[k * 64 + tid];
            y += Dh * xs_s[tid]; const float z = bf2f(MX[row * LDMX + SZ + hd * 64 + tid]);
            BR[row * LDBR + 1024 + hd * 64 + tid] = (bf16_t)f2bf(y * siluf_(z)); }
        __syncthreads();
    }
}
__device__ __forceinline__ void hg_simple(const Params& p, int l, int unit, LAS unsigned char* lds) {
    const int tid = opaque_tid(), e = tid & 127, dq = tid >> 7; const int b = unit >> 2, hd = unit & 3;
    const bf16_t* MX = (const bf16_t*)(p.ws + WS_MX); bf16_t* BR = (bf16_t*)(p.ws + WS_BR);
    LAS float* f_s = (LAS float*)lds; LAS float* k_s = f_s + 128; LAS float* q_s = k_s + 128; LAS float* v_s = q_s + 128; LAS float* part = v_s + 128;
    const float lb = hgrn_lb(p, l, hd * 128 + e);
    float h[32];
#pragma unroll
    for (int i = 0; i < 32; ++i) h[i] = 0.f;
    for (int r = PADF; r < TP; ++r) {
        const size_t row = (size_t)b * TP + r; const bf16_t* mx = MX + row * LDMX;
        if (tid < 128) { const float qraw = bf2f(mx[HQ + hd * 128 + tid]), fraw = bf2f(mx[HF + hd * 128 + tid]); const float f = lb + (1.f - lb) * sigmoidf_(fraw);
            f_s[tid] = f; k_s[tid] = 1.f - f; q_s[tid] = siluf_(qraw); }
        else if (tid < 256) v_s[tid - 128] = bf2f(mx[HI + hd * 128 + (tid - 128)]);
        __syncthreads();
        const float v = v_s[e]; float pt = 0.f;
#pragma unroll
        for (int i = 0; i < 32; ++i) { const int d = dq * 32 + i; h[i] = f_s[d] * h[i] + k_s[d] * v; pt += h[i] * q_s[d]; }
        part[dq * 128 + e] = pt;
        __syncthreads();
        if (tid < 128) BR[row * LDBR + 1536 + hd * 128 + tid] = (bf16_t)f2bf(part[tid] + part[128 + tid] + part[256 + tid] + part[384 + tid]);
        __syncthreads();
    }
}


__device__ __forceinline__ bf16x8 ldfrag(const LAS bf16_t* base, int row, int stride, int k) { return *(const LAS bf16x8*)(base + row * stride + k); }
#define MFMA16(a, b, c) __builtin_amdgcn_mfma_f32_16x16x32_bf16(a, b, c, 0, 0, 0)

template <int NT>
__device__ __forceinline__ void meta_tiles(LAS unsigned char* lds, const bf16_t* const (&Ap)[NT], int lda, const bf16_t* const (&Bp)[NT], int ldb, int K, int w, int lane, f32x4 (&out)[NT]) {
    const int r16 = lane & 15, q4 = lane >> 4, ks = K >> 3;
    f32x4 acc[NT][4];
#pragma unroll
    for (int t = 0; t < NT; ++t)
#pragma unroll
        for (int m = 0; m < 4; ++m) acc[t][m] = (f32x4){0.f, 0.f, 0.f, 0.f};
#pragma unroll
    for (int t = 0; t < NT; ++t) {
        const bf16_t* bp = Bp[t] + (size_t)r16 * ldb + w * ks + q4 * 8; const bf16_t* ap = Ap[t] + (size_t)r16 * lda + w * ks + q4 * 8;
#pragma unroll 4
        for (int k0 = 0; k0 < ks; k0 += 32) { const bf16x8 bfr = *(const bf16x8*)(bp + k0);
#pragma unroll
            for (int m = 0; m < 4; ++m) acc[t][m] = MFMA16(bfr, *(const bf16x8*)(ap + (size_t)m * 16 * lda + k0), acc[t][m]); } }
    LAS f32x4* red = (LAS f32x4*)lds;
    __syncthreads();
#pragma unroll
    for (int t = 0; t < NT; ++t)
#pragma unroll
        for (int m = 0; m < 4; ++m) red[((w * NT + t) * 4 + m) * 64 + lane] = acc[t][m];
    __syncthreads();
#pragma unroll
    for (int t = 0; t < NT; ++t) { f32x4 v = (f32x4){0.f, 0.f, 0.f, 0.f};
        if (w < 4) {
#pragma unroll
            for (int ww = 0; ww < 8; ++ww) v = v + red[((ww * NT + t) * 4 + w) * 64 + lane]; }
        out[t] = v; }
}
__device__ __forceinline__ f32x4 meta_tile(LAS unsigned char* lds, const bf16_t* A, int lda, const bf16_t* Bt, int ldb, int K, int brow0, int w, int lane) {
    const bf16_t* const Ap[1] = {A}; const bf16_t* const Bp[1] = {Bt + (size_t)brow0 * ldb}; f32x4 o[1];
    meta_tiles<1>(lds, Ap, lda, Bp, ldb, K, w, lane, o); return o[0];
}

#define META_IDS() const int tid = opaque_tid(), lane = tid & 63, w = __builtin_amdgcn_readfirstlane(tid >> 6), r16 = lane & 15, q4 = lane >> 4; const int row = w * 16 + r16; (void)row; (void)q4
__device__ __forceinline__ void meta_proj(const Params& p, LAS unsigned char* lds) {
    META_IDS();
    const bf16_t* U = (const bf16_t*)(p.ws + WS_U); const bf16_t* W = (const bf16_t*)(p.ws + WS_WIN);
    bf16_t* MX = (bf16_t*)(p.ws + WS_MX); bf16_t* G = (bf16_t*)(p.ws + WS_G); bf16_t* DT = (bf16_t*)(p.ws + WS_DT);
    const int mj0 = gridDim.x == 256 ? (int)blockIdx.x - 192 : (int)blockIdx.x, mjs = gridDim.x == 256 ? 64 : (int)gridDim.x;
    if (mj0 >= 0) for (int j = mj0; j < NPROJ / 16; j += mjs) {
        const f32x4 v = meta_tile(lds, U, 1024, W, 1024, 1024, j * 16, w, lane);
        if (w < 4) { const int col = j * 16 + q4 * 4;
            if (col >= 5632 && col < 9728) *(unsigned*)((unsigned char*)G + (size_t)row * LDG + (col - 5632)) = gate_q8x4(v[0], v[1], v[2], v[3]);
            else { bf16_t* dst = col < 5632 ? MX + (size_t)row * LDMX + col : DT + (size_t)row * LDDT + (col - 9728);
                const int ct = col >> 8; f32x4 o = v;
                if (ct == 4 || ct == 5 || ct == 8 || ct == 9 || ct == 14 || ct == 15 || ct == 20 || ct == 21) o = (f32x4){siluf_(v[0]), siluf_(v[1]), siluf_(v[2]), siluf_(v[3])};
                *(u32x2*)dst = (u32x2){pk2(o[0], o[1]), pk2(o[2], o[3])}; } } }
}
__device__ __forceinline__ void meta_glu(const Params& p, int l, LAS unsigned char* lds) {
    META_IDS();
    const bf16_t* A = (const bf16_t*)(p.ws + WS_S5P); const bf16_t* W = (const bf16_t*)(p.ws + WS_WGLU); bf16_t* BR = (bf16_t*)(p.ws + WS_BR);
    for (int j = blockIdx.x; j < 32; j += gridDim.x) { const int oc0 = j * 16, arow0 = (oc0 >> 7) * 256 + (oc0 & 127);
        const bf16_t* const Ap[2] = {A, A}; const bf16_t* const Bp[2] = {W + (size_t)arow0 * 512, W + (size_t)(arow0 + 128) * 512}; f32x4 vv[2];
        meta_tiles<2>(lds, Ap, 512, Bp, 512, 512, w, lane, vv); const f32x4 va = vv[0], vg = vv[1];
        if (w < 4) { const int oc = oc0 + q4 * 4; const f32x4 ba = *(const f32x4*)(p.in[21] + l * 1024 + oc), bg = *(const f32x4*)(p.in[21] + l * 1024 + 512 + oc);
            f32x4 o;
#pragma unroll
            for (int i = 0; i < 4; ++i) o[i] = (va[i] + ba[i]) * sigmoidf_(vg[i] + bg[i]);
            *(u32x2*)(BR + (size_t)row * LDBR + 512 + oc) = (u32x2){pk2(o[0], o[1]), pk2(o[2], o[3])}; } }
}
__device__ __forceinline__ void meta_merge(const Params& p, LAS unsigned char* lds) {
    META_IDS();
    const bf16_t* BR = (const bf16_t*)(p.ws + WS_BR); const bf16_t* W = (const bf16_t*)(p.ws + WS_WBR); const bf16_t* G = (const bf16_t*)(p.ws + WS_G); bf16_t* O = (bf16_t*)(p.ws + WS_MIXP);
    for (int j = blockIdx.x; j < 64; j += gridDim.x) { f32x4 tot = (f32x4){0.f, 0.f, 0.f, 0.f}; const int col = j * 16 + q4 * 4;
        const bf16_t* const Ap[4] = {BR, BR + 512, BR + 1024, BR + 1536};
        const bf16_t* const Bp[4] = {W + (size_t)(j * 16) * 512, W + ((size_t)1024 + j * 16) * 512, W + ((size_t)2048 + j * 16) * 512, W + ((size_t)3072 + j * 16) * 512};
        f32x4 vz[4]; meta_tiles<4>(lds, Ap, LDBR, Bp, 512, 512, w, lane, vz);
#pragma unroll
        for (int z = 0; z < 4; ++z) { const f32x4 v = vz[z];
            if (w < 4) { const unsigned gw = *(const unsigned*)((const unsigned char*)G + (size_t)row * LDG + z * 1024 + col);
                tot = tot + (f32x4){gate_s(gw, 0), gate_s(gw, 1), gate_s(gw, 2), gate_s(gw, 3)} * (1.f / 256.f) * v; } }
        if (w < 4) *(u32x2*)(O + (size_t)row * 1024 + col) = (u32x2){pk2(tot[0], tot[1]), pk2(tot[2], tot[3])}; }
}
__device__ __forceinline__ void meta_f32(const Params& p, const bf16_t* A, int K, const bf16_t* W, LAS unsigned char* lds) {
    META_IDS();
    bf16_t* D = (bf16_t*)(p.ws + WS_DELTA);
    for (int j = blockIdx.x; j < 64; j += gridDim.x) { const f32x4 v = meta_tile(lds, A, K, W, K, K, j * 16, w, lane);
        if (w < 4) *(u32x2*)(D + (size_t)row * 1024 + j * 16 + q4 * 4) = (u32x2){pk2(v[0], v[1]), pk2(v[2], v[3])}; }
}
__device__ __forceinline__ void meta_up(const Params& p, LAS unsigned char* lds) {
    META_IDS();
    const bf16_t* U = (const bf16_t*)(p.ws + WS_U); const bf16_t* W = (const bf16_t*)(p.ws + WS_WUP); bf16_t* O = (bf16_t*)(p.ws + WS_G);
    for (int j = blockIdx.x; j < 256; j += gridDim.x) { f32x4 v = meta_tile(lds, U, 1024, W, 1024, 1024, j * 16, w, lane);
        if (w < 4) {
#pragma unroll
            for (int i = 0; i < 4; ++i) { const float a = fmaxf(v[i], 0.f); v[i] = a * a; }
            *(u32x2*)(O + (size_t)row * DFF + j * 16 + q4 * 4) = (u32x2){pk2(v[0], v[1]), pk2(v[2], v[3])}; } }
}
constexpr int A_QS = 0, A_KS = 17408, A_QX = 34816, A_KT = 52224, A_VT = 70656, A_PP = 79872, A_ST0 = 89088, A_ST1 = 106496, A_XS = 123904, A_CUM = 133120, A_DEC = 133632, A_TOT = 134144, A_DTA = 136192, A_CUMA = 144640;
static_assert(A_CUMA + 2112 * 4 + 16 <= LDS_BYTES, "lds");

template <int MODE>
__device__ __forceinline__ void attn_unit(const Params& p, int l, int unit, LAS unsigned char* lds) {
    constexpr int DK = MODE == 0 ? 64 : 128, SD = DK + 8, ST = 72, TPW = DK / 32;
    const int tid = opaque_tid(), lane = tid & 63, w = __builtin_amdgcn_readfirstlane(tid >> 6), r16 = lane & 15, q4 = lane >> 4;
    const int b = unit >> 3, hd = MODE == 1 ? (unit & 7) : ((unit >> 1) & 3), half = MODE == 1 ? 0 : (unit & 1), g = hd >> 2;
    const bf16_t* MX = (const bf16_t*)(p.ws + WS_MX); bf16_t* BR = (bf16_t*)(p.ws + WS_BR); const bf16_t* DT = (const bf16_t*)(p.ws + WS_DT); const bf16_t* XBC = (const bf16_t*)(p.ws + WS_XBC);
    LAS bf16_t* QS = (LAS bf16_t*)(lds + A_QS); LAS bf16_t* KS = (LAS bf16_t*)(lds + A_KS); LAS bf16_t* QX = (LAS bf16_t*)(lds + A_QX); LAS bf16_t* KT = (LAS bf16_t*)(lds + A_KT);
    LAS bf16_t* VT = (LAS bf16_t*)(lds + A_VT); LAS bf16_t* PP = (LAS bf16_t*)(lds + A_PP); LAS bf16_t* XS = (LAS bf16_t*)(lds + A_XS);
    LAS float* CUM0 = (LAS float*)(lds + A_CUM); LAS float* DEC = (LAS float*)(lds + A_DEC); LAS float* TOT = (LAS float*)(lds + A_TOT);
    LAS float* DTA = (LAS float*)(lds + A_DTA); LAS float* CUMA = (LAS float*)(lds + A_CUMA);
    float lg = 0.f, Dh = 0.f, lbv = 0.f; float invf_t[4] = {0.f, 0.f, 0.f, 0.f};
    if (MODE == 0) { lg = logf(1.f - exp2f(-5.f - (float)hd));
#pragma unroll
        for (int j = 0; j < 4; ++j) invf_t[j] = exp2f(-(float)((tid & 7) * 4 + j) * (13.287712379549449f / 32.f)) * 0.15915494309f; }
    if (MODE == 2) lbv = hgrn_lb(p, l, hd * 128 + (tid & 127));
    const int VBASE = MODE == 0 ? RV + hd * 128 + half * 64 : HI + hd * 128 + half * 64;
    const int OBASE = MODE == 0 ? hd * 128 + half * 64 : (MODE == 1 ? 1024 + hd * 64 : 1536 + hd * 128 + half * 64);
    __syncthreads();
    if (MODE == 1) {
        Dh = p.in[26][l * 8 + hd];
        const float a_h = -expf(p.in[25][l * 8 + hd]), dtb = p.in[24][l * 8 + hd];
        for (int r = tid; r < TP; r += 512) { const float dt = softplusf_(bf2f(DT[(r < 64 ? (size_t)r : (size_t)b * TP + r) * LDDT + hd]) + dtb); DTA[r] = dt; CUMA[r] = r < PADF ? 0.f : dt * a_h; }
        __syncthreads();
        for (int c = w; c < 33; c += 8) { float cum = CUMA[c * 64 + lane];
#pragma unroll
            for (int o = 1; o < 64; o <<= 1) { const float v = __shfl_up(cum, o); if (lane >= o) cum += v; }
            CUMA[c * 64 + lane] = cum; }
    } else { if (tid < 64) CUM0[tid] = MODE == 0 ? (float)(tid + 1) * lg : 0.f; }
    for (int i = tid; i < 64 * SD / 2; i += 512) ((LAS unsigned*)(lds + A_ST0))[i] = 0u;
    f32x4 st[TPW];
#pragma unroll
    for (int i = 0; i < TPW; ++i) st[i] = (f32x4){0.f, 0.f, 0.f, 0.f};
    u32x2 rq[4]; u32x4 rv; unsigned short hq[16], hf[16]; u32x4 rrow[6];
    auto load_raw = [&](int c) {
        const size_t row0 = c == 0 ? (size_t)0 : (size_t)b * TP + c * 64;
        if (MODE == 0) { const int t = tid >> 3, i0 = (tid & 7) * 4; const bf16_t* mx = MX + (row0 + t) * LDMX;
            rq[0] = *(const u32x2*)(mx + RQ + hd * 64 + i0); rq[1] = *(const u32x2*)(mx + RQ + hd * 64 + 32 + i0); rq[2] = *(const u32x2*)(mx + RK + hd * 64 + i0); rq[3] = *(const u32x2*)(mx + RK + hd * 64 + 32 + i0); }
        if (MODE == 2) { const int d = tid & 127, tq = tid >> 7;
#pragma unroll
            for (int i = 0; i < 16; ++i) { const bf16_t* mx = MX + (row0 + tq * 16 + i) * LDMX; hq[i] = mx[HQ + hd * 128 + d]; hf[i] = mx[HF + hd * 128 + d]; } }
        if (MODE == 0 || MODE == 2) { const int t = tid >> 3, e0 = (tid & 7) * 8; rv = *(const u32x4*)(MX + (row0 + t) * LDMX + VBASE + e0); }
        if (MODE == 1) {
#pragma unroll
            for (int k = 0; k < 3; ++k) { const int pt = tid + 512 * k; if (pt < 1280) { const int cgq = pt >> 5, u = pt & 31;
                const int chq = cgq < 8 ? hd * 64 + cgq * 8 : (cgq < 24 ? 512 + g * 128 + (cgq - 8) * 8 : 768 + g * 128 + (cgq - 24) * 8);
                rrow[2 * k] = *(const u32x4*)(XBC + (row0 + 2 * u) * 1024 + chq); rrow[2 * k + 1] = *(const u32x4*)(XBC + (row0 + 2 * u + 1) * 1024 + chq); } } }
    };
    __syncthreads();
    load_raw(0);
    for (int c = 0; c < 33; ++c) {
        const size_t row0 = (size_t)b * TP + c * 64;
        const LAS bf16_t* STc = (const LAS bf16_t*)(lds + ((c & 1) ? A_ST1 : A_ST0)); LAS bf16_t* STn = (LAS bf16_t*)(lds + ((c & 1) ? A_ST0 : A_ST1));
        const LAS float* CUM = MODE == 1 ? (const LAS float*)(CUMA + c * 64) : (const LAS float*)CUM0;
        u32x2 zw[2];
        if (MODE == 1) {
#pragma unroll
            for (int i = 0; i < 2; ++i) { const int ti = w * 2 + i, mt = ti >> 2, nt = ti & 3; zw[i] = *(const u32x2*)(MX + ((c == 0 ? (size_t)0 : row0) + mt * 16 + r16) * LDMX + SZ + hd * 64 + nt * 16 + q4 * 4); } }
        if (MODE == 0) {
            const int t = tid >> 3, i0 = (tid & 7) * 4;
            const float q1[4] = {bflo(rq[0].x), bfhi(rq[0].x), bflo(rq[0].y), bfhi(rq[0].y)}, q2[4] = {bflo(rq[1].x), bfhi(rq[1].x), bflo(rq[1].y), bfhi(rq[1].y)};
            const float k1[4] = {bflo(rq[2].x), bfhi(rq[2].x), bflo(rq[2].y), bfhi(rq[2].y)}, k2[4] = {bflo(rq[3].x), bfhi(rq[3].x), bflo(rq[3].y), bfhi(rq[3].y)};
            const float pos = (float)(c * 64 + t - PADF), eq = __expf((float)(t + 1) * lg), ek = __expf((float)(63 - t) * lg);
            float a1[4], a2[4], b1[4], b2[4];
#pragma unroll
            for (int j = 0; j < 4; ++j) { float sn, cs; sincos_turns(pos * invf_t[j], sn, cs);
                a1[j] = q1[j] * cs - q2[j] * sn; a2[j] = q1[j] * sn + q2[j] * cs; b1[j] = (k1[j] * cs - k2[j] * sn) * 0.125f; b2[j] = (k1[j] * sn + k2[j] * cs) * 0.125f; }
            *(LAS u32x2*)(QS + t * SD + i0) = (u32x2){pk2(a1[0], a1[1]), pk2(a1[2], a1[3])}; *(LAS u32x2*)(QS + t * SD + 32 + i0) = (u32x2){pk2(a2[0], a2[1]), pk2(a2[2], a2[3])};
            *(LAS u32x2*)(QX + t * SD + i0) = (u32x2){pk2(a1[0] * eq, a1[1] * eq), pk2(a1[2] * eq, a1[3] * eq)}; *(LAS u32x2*)(QX + t * SD + 32 + i0) = (u32x2){pk2(a2[0] * eq, a2[1] * eq), pk2(a2[2] * eq, a2[3] * eq)};
            *(LAS u32x2*)(KS + t * SD + i0) = (u32x2){pk2(b1[0], b1[1]), pk2(b1[2], b1[3])}; *(LAS u32x2*)(KS + t * SD + 32 + i0) = (u32x2){pk2(b2[0], b2[1]), pk2(b2[2], b2[3])};
#pragma unroll
            for (int j = 0; j < 4; ++j) { KT[(i0 + j) * ST + t] = (bf16_t)f2bf(b1[j] * ek); KT[(32 + i0 + j) * ST + t] = (bf16_t)f2bf(b2[j] * ek); }
        }
        if (MODE == 0 || MODE == 2) {
            const int t = tid >> 3, e0 = (tid & 7) * 8; const u32x4 vw = rv;
            VT[(e0 + 0) * ST + t] = (bf16_t)(vw.x & 0xffffu); VT[(e0 + 1) * ST + t] = (bf16_t)(vw.x >> 16); VT[(e0 + 2) * ST + t] = (bf16_t)(vw.y & 0xffffu); VT[(e0 + 3) * ST + t] = (bf16_t)(vw.y >> 16);
            VT[(e0 + 4) * ST + t] = (bf16_t)(vw.z & 0xffffu); VT[(e0 + 5) * ST + t] = (bf16_t)(vw.z >> 16); VT[(e0 + 6) * ST + t] = (bf16_t)(vw.w & 0xffffu); VT[(e0 + 7) * ST + t] = (bf16_t)(vw.w >> 16);
        }
        if (MODE == 2) {
            const int d = tid & 127, tq = tid >> 7;
            float lp[16], kv[16], qv[16]; float run = 1.f; const float oml = 1.f - lbv; const bool padchunk = c == 0;
#pragma unroll
            for (int i = 0; i < 16; ++i) { const int t = tq * 16 + i;
                const float qraw = bf2f(hq[i]), fraw = bf2f(hf[i]);
                const float e = __expf(-fraw), r = __builtin_amdgcn_rcpf(1.f + e);
                float f = (1.f + lbv * e) * r, kk = oml * e * r;
                if (padchunk && t < PADF) { f = 1.f; kk = 0.f; }
                run *= f; lp[i] = run; kv[i] = kk; qv[i] = qraw; }
            TOT[tq * 128 + d] = run;
            if (c + 1 < 33) load_raw(c + 1);
            LBAR();
            const float t0 = TOT[d], t1 = TOT[128 + d], t2 = TOT[256 + d], t3 = TOT[384 + d];
            const float pre = (tq > 0 ? t0 : 1.f) * (tq > 1 ? t1 : 1.f) * (tq > 2 ? t2 : 1.f);
            const float cE = tq == 0 ? __builtin_amdgcn_rcpf(t0) * __builtin_amdgcn_rcpf(t1) : (tq == 1 ? __builtin_amdgcn_rcpf(t1) : (tq == 2 ? 1.f : t2));
            const float e63r = t2 * t3;
#pragma unroll
            for (int i4 = 0; i4 < 16; i4 += 4) { float kw[4];
#pragma unroll
                for (int ii = 0; ii < 4; ++ii) { const int i = i4 + ii, t = tq * 16 + i; const float E1 = lp[i] * cE, inv = __builtin_amdgcn_rcpf(E1);
                    const unsigned qq = pk2(qv[i] * E1, qv[i] * (pre * lp[i]));
                    QS[t * SD + d] = (bf16_t)(qq & 0xffffu); QX[t * SD + d] = (bf16_t)(qq >> 16); KS[t * SD + d] = (bf16_t)f2bf(kv[i] * inv); kw[ii] = kv[i] * inv * e63r; }
                *(LAS u32x2*)(KT + d * ST + tq * 16 + i4) = (u32x2){pk2(kw[0], kw[1]), pk2(kw[2], kw[3])}; }
            if (tq == 0) DEC[d] = (t0 * t1) * (t2 * t3);
        }
        if (MODE == 1) {
            const float c63 = CUM[63];
            const int ta_ = 2 * (tid & 31);
            const float cum0 = CUM[ta_], cum1 = CUM[ta_ + 1], dt0 = DTA[c * 64 + ta_], dt1 = DTA[c * 64 + ta_ + 1];
#pragma unroll
            for (int k = 0; k < 3; ++k) { const int pt = tid + 512 * k; if (pt < 1280) { const int cgq = pt >> 5, u = pt & 31, ta = 2 * u;
                float o[2][8]; unpack8(rrow[2 * k], o[0]); unpack8(rrow[2 * k + 1], o[1]);
                if (cgq < 8) { const int e0 = cgq * 8;
                    *(LAS u32x4*)(XS + ta * ST + e0) = rrow[2 * k]; *(LAS u32x4*)(XS + (ta + 1) * ST + e0) = rrow[2 * k + 1];
#pragma unroll
                    for (int j = 0; j < 8; ++j) *(LAS unsigned*)(VT + (e0 + j) * ST + ta) = pk2(o[0][j] * dt0, o[1][j] * dt1); }
                else if (cgq < 24) { const int n0 = (cgq - 8) * 8; const float wk0 = __expf(c63 - cum0), wk1 = __expf(c63 - cum1);
                    *(LAS u32x4*)(KS + ta * SD + n0) = rrow[2 * k]; *(LAS u32x4*)(KS + (ta + 1) * SD + n0) = rrow[2 * k + 1];
#pragma unroll
                    for (int j = 0; j < 8; ++j) *(LAS unsigned*)(KT + (n0 + j) * ST + ta) = pk2(o[0][j] * wk0, o[1][j] * wk1); }
                else { const int n0 = (cgq - 24) * 8; const float eq0 = __expf(cum0), eq1 = __expf(cum1);
                    *(LAS u32x4*)(QS + ta * SD + n0) = rrow[2 * k]; *(LAS u32x4*)(QS + (ta + 1) * SD + n0) = rrow[2 * k + 1];
#pragma unroll
                    for (int j = 0; j < 8; ++j) { o[0][j] *= eq0; o[1][j] *= eq1; }
                    *(LAS u32x4*)(QX + ta * SD + n0) = pack8(o[0]); *(LAS u32x4*)(QX + (ta + 1) * SD + n0) = pack8(o[1]); }
            } }
        }
        if (MODE != 2) { if (c + 1 < 33) load_raw(c + 1); }
        LBAR();
        {   const int mtS = w >> 1;
            f32x4 accS[2] = {(f32x4){0.f, 0.f, 0.f, 0.f}, (f32x4){0.f, 0.f, 0.f, 0.f}};
#pragma unroll
            for (int k0 = 0; k0 < DK; k0 += 32) { const bf16x8 qa = ldfrag(QS, mtS * 16 + r16, SD, k0 + q4 * 8);
#pragma unroll
                for (int i = 0; i < 2; ++i) accS[i] = MFMA16(qa, ldfrag(KS, ((w * 2 + i) & 3) * 16 + r16, SD, k0 + q4 * 8), accS[i]); }
            const f32x4 ct = *(const LAS f32x4*)(CUM + mtS * 16 + q4 * 4);
            float csv[2];
#pragma unroll
            for (int i = 0; i < 2; ++i) csv[i] = CUM[((w * 2 + i) & 3) * 16 + r16];
#pragma unroll
            for (int i = 0; i < 2; ++i) { const int s = ((w * 2 + i) & 3) * 16 + r16;
#pragma unroll
                for (int j = 0; j < 4; ++j) { const int t = mtS * 16 + q4 * 4 + j; const float v = (s <= t) ? accS[i][j] * __expf(ct[j] - csv[i]) : 0.f; PP[t * ST + s] = (bf16_t)f2bf(v); } }
        }
        LBAR();
        {   const int mtY = w >> 1;
            f32x4 accY[2] = {(f32x4){0.f, 0.f, 0.f, 0.f}, (f32x4){0.f, 0.f, 0.f, 0.f}};
#pragma unroll
            for (int k0 = 0; k0 < 64; k0 += 32) { const bf16x8 pa = ldfrag(PP, mtY * 16 + r16, ST, k0 + q4 * 8);
#pragma unroll
                for (int i = 0; i < 2; ++i) accY[i] = MFMA16(ldfrag(VT, ((w * 2 + i) & 3) * 16 + r16, ST, k0 + q4 * 8), pa, accY[i]); }
#pragma unroll
            for (int k0 = 0; k0 < DK; k0 += 32) { const bf16x8 qa = ldfrag(QX, mtY * 16 + r16, SD, k0 + q4 * 8);
#pragma unroll
                for (int i = 0; i < 2; ++i) accY[i] = MFMA16(ldfrag(STc, ((w * 2 + i) & 3) * 16 + r16, SD, k0 + q4 * 8), qa, accY[i]); }
            u32x2 xw[2];
            if (MODE == 1) {
#pragma unroll
                for (int i = 0; i < 2; ++i) xw[i] = *(const LAS u32x2*)(XS + (mtY * 16 + r16) * ST + ((w * 2 + i) & 3) * 16 + q4 * 4); }
            const float decs = MODE == 0 ? __expf(64.f * lg) : (MODE == 1 ? __expf(CUM[63]) : 1.f);
            f32x4 accT[TPW];
#pragma unroll
            for (int i = 0; i < TPW; ++i) { const int ti = w * TPW + i, mt = ti >> 2;
                if (MODE == 2) { const f32x4 dv = *(const LAS f32x4*)(DEC + mt * 16 + q4 * 4); accT[i] = st[i] * dv; } else accT[i] = st[i] * decs; }
#pragma unroll
            for (int k0 = 0; k0 < 64; k0 += 32)
#pragma unroll
                for (int i = 0; i < TPW; ++i) { const int ti = w * TPW + i, mt = ti >> 2, nt = ti & 3;
                    accT[i] = MFMA16(ldfrag(KT, mt * 16 + r16, ST, k0 + q4 * 8), ldfrag(VT, nt * 16 + r16, ST, k0 + q4 * 8), accT[i]); }
#pragma unroll
            for (int i = 0; i < 2; ++i) { const int nt = (w * 2 + i) & 3; f32x4 acc = accY[i];
                const int t = mtY * 16 + r16, e0 = nt * 16 + q4 * 4; const size_t row = row0 + t;
                if (MODE == 1) {
                    acc[0] = (acc[0] + Dh * bflo(xw[i].x)) * bflo(zw[i].x); acc[1] = (acc[1] + Dh * bfhi(xw[i].x)) * bfhi(zw[i].x);
                    acc[2] = (acc[2] + Dh * bflo(xw[i].y)) * bflo(zw[i].y); acc[3] = (acc[3] + Dh * bfhi(xw[i].y)) * bfhi(zw[i].y); }
                *(u32x2*)(BR + row * LDBR + OBASE + e0) = (u32x2){pk2(acc[0], acc[1]), pk2(acc[2], acc[3])}; }
#pragma unroll
            for (int i = 0; i < TPW; ++i) { const int ti = w * TPW + i, mt = ti >> 2, nt = ti & 3; st[i] = accT[i];
                *(LAS u32x2*)(STn + (nt * 16 + r16) * SD + mt * 16 + q4 * 4) = (u32x2){pk2(accT[i][0], accT[i][1]), pk2(accT[i][2], accT[i][3])}; }
        }
        LBAR();
    }
}

constexpr int S_US = 0, S_BBT = 4608, S_CC = 20992, S_BU = 38400, S_X = 103936;
static_assert(S_X + 4 * 32 * 136 * 2 <= LDS_BYTES, "lds");
__device__ __forceinline__ void s5_unit(const Params& p, int l, int unit, LAS unsigned char* lds) {
    const int tid = opaque_tid(), lane = tid & 63, w = __builtin_amdgcn_readfirstlane(tid >> 6), r16 = lane & 15, q4 = lane >> 4;
    const int b = unit >> 3, gb = unit & 7;
    const bf16_t* MX = (const bf16_t*)(p.ws + WS_MX); bf16_t* S5P = (bf16_t*)(p.ws + WS_S5P);
    LAS bf16_t* US = (LAS bf16_t*)(lds + S_US); LAS bf16_t* BBT = (LAS bf16_t*)(lds + S_BBT); LAS bf16_t* CC = (LAS bf16_t*)(lds + S_CC); LAS float* BU = (LAS float*)(lds + S_BU); LAS bf16_t* X = (LAS bf16_t*)(lds + S_X);
    __syncthreads();
    float ar = 0.f, ai = 0.f, xr = 0.f, xi = 0.f;
    const int gi_s = tid >> 6, pp = tid & 63;
    if (tid < 256) {
        const int g = gb * 4 + gi_s, gp = (l * 32 + g) * 64 + pp;
        const float step = expf(p.in[19][l * 32 + g]), lr = p.in[12][gp], li = p.in[13][gp];
        const float mag = expf(lr * step); float sn, cs; sincos_turns(li * step * 0.15915494309f, sn, cs);
        ar = mag * cs; ai = mag * sn; const float inv = 1.f / (lr * lr + li * li);
        const float cor = ((ar - 1.f) * lr + ai * li) * inv, coi = (ai * lr - (ar - 1.f) * li) * inv;
#pragma unroll
        for (int j = 0; j < 16; ++j) { const float br = p.in[14][(size_t)gp * 16 + j], bi = p.in[15][(size_t)gp * 16 + j];
            BBT[(gi_s * 128 + pp) * 16 + j] = (bf16_t)f2bf(cor * br - coi * bi); BBT[(gi_s * 128 + 64 + pp) * 16 + j] = (bf16_t)f2bf(cor * bi + coi * br);
            CC[(gi_s * 16 + j) * 136 + pp] = (bf16_t)f2bf(p.in[16][((size_t)(l * 32 + g) * 16 + j) * 64 + pp]); CC[(gi_s * 16 + j) * 136 + 64 + pp] = (bf16_t)f2bf(-p.in[17][((size_t)(l * 32 + g) * 16 + j) * 64 + pp]); }
    }
    __syncthreads();
    const int gi_w = w >> 1, mt_w = w & 1;
    const float* dskp = p.in[18] + l * 512 + gb * 64 + gi_w * 16 + q4 * 4;
    auto urow = [&](int s) -> size_t { return (s < 2 ? (size_t)(s * 32) : (size_t)b * TP + s * 32) + mt_w * 16 + r16; };
    bf16x8 bbf[8], ccf[4];
#pragma unroll
    for (int nt = 0; nt < 8; ++nt) { bbf[nt] = (bf16x8){0, 0, 0, 0, 0, 0, 0, 0}; if (q4 < 2) bbf[nt] = ldfrag(BBT, gi_w * 128 + nt * 16 + r16, 16, q4 * 8); }
#pragma unroll
    for (int k = 0; k < 4; ++k) ccf[k] = ldfrag(CC, gi_w * 16 + r16, 136, k * 32 + q4 * 8);
    bf16x8 afr = (bf16x8){0, 0, 0, 0, 0, 0, 0, 0}; u32x2 uw;
    if (q4 < 2) afr = *(const bf16x8*)(MX + urow(0) * LDMX + S5U + gb * 64 + gi_w * 16 + q4 * 8);
    uw = *(const u32x2*)(MX + urow(0) * LDMX + S5U + gb * 64 + gi_w * 16 + q4 * 4);
    for (int s = 0; s < 66; ++s) {
        const size_t row0 = (size_t)b * TP + s * 32;
#pragma unroll
        for (int nt = 0; nt < 8; ++nt) {
            const f32x4 acc = MFMA16(afr, bbf[nt], ((f32x4){0.f, 0.f, 0.f, 0.f}));
#pragma unroll
            for (int j = 0; j < 4; ++j) BU[(gi_w * 32 + mt_w * 16 + q4 * 4 + j) * 128 + nt * 16 + r16] = acc[j]; }
        const u32x2 uwc = uw;
        if (s + 1 < 66) { if (q4 < 2) afr = *(const bf16x8*)(MX + urow(s + 1) * LDMX + S5U + gb * 64 + gi_w * 16 + q4 * 8);
            uw = *(const u32x2*)(MX + urow(s + 1) * LDMX + S5U + gb * 64 + gi_w * 16 + q4 * 4); }
        LBAR();
        if (tid < 256) {
            float bur_[32], bui_[32];
#pragma unroll
            for (int t = 0; t < 32; ++t) { bur_[t] = BU[(gi_s * 32 + t) * 128 + pp]; bui_[t] = BU[(gi_s * 32 + t) * 128 + 64 + pp]; }
#pragma unroll
            for (int t = 0; t < 32; ++t) { const float bur = bur_[t], bui = bui_[t];
                const float nxr = ar * xr - ai * xi + bur, nxi = ar * xi + ai * xr + bui; xr = nxr; xi = nxi;
                const unsigned pk = pk2(xr, xi); X[(gi_s * 32 + t) * 136 + pp] = (bf16_t)(pk & 0xffffu); X[(gi_s * 32 + t) * 136 + 64 + pp] = (bf16_t)(pk >> 16); } }
        LBAR();
        { f32x4 acc = (f32x4){0.f, 0.f, 0.f, 0.f};
#pragma unroll
            for (int k0 = 0; k0 < 128; k0 += 32) acc = MFMA16(ccf[k0 >> 5], ldfrag(X, gi_w * 32 + mt_w * 16 + r16, 136, k0 + q4 * 8), acc);
            const int t = mt_w * 16 + r16, ch = gi_w * 16 + q4 * 4;
            const f32x4 dsk = *(const f32x4*)dskp;
            const float y0 = geluf_(acc[0] + dsk[0] * bflo(uwc.x)), y1 = geluf_(acc[1] + dsk[1] * bfhi(uwc.x)), y2 = geluf_(acc[2] + dsk[2] * bflo(uwc.y)), y3 = geluf_(acc[3] + dsk[3] * bfhi(uwc.y));
            *(u32x2*)(S5P + (row0 + t) * 512 + gb * 64 + ch) = (u32x2){pk2(y0, y1), pk2(y2, y3)}; }
    }
    __syncthreads();
}

__device__ __forceinline__ void mixer_phase(const Params& p, int l, LAS unsigned char* lds) {
    const int G = gridDim.x, bx = blockIdx.x, wave = opaque_tid() >> 6;
    constexpr int N_SSD = 64, N_HG = FAST_HG ? 64 : 32, N_RET = FAST_RET ? 64 : 0, N_S5 = FAST_S5 ? 64 : 0, NW = N_SSD + N_HG + N_RET + N_S5;
    for (int u0 = bx; u0 < NW; u0 += G) { int u = u0;
        if (u < N_SSD) {
#if FAST_SSD
            attn_unit<1>(p, l, u, lds); if (MIXREP & 1) attn_unit<1>(p, l, u, lds);
#else
            ssd_simple(p, l, u, lds);
#endif
            continue; } u -= N_SSD;
        if (u < N_HG) {
#if FAST_HG
            attn_unit<2>(p, l, u, lds); if (MIXREP & 2) attn_unit<2>(p, l, u, lds);
#else
            hg_simple(p, l, u, lds);
#endif
            continue; } u -= N_HG;
#if FAST_RET
        if (u < N_RET) { attn_unit<0>(p, l, u, lds); if (MIXREP & 4) attn_unit<0>(p, l, u, lds); continue; } u -= N_RET;
#endif
#if FAST_S5
        s5_unit(p, l, u, lds); if (MIXREP & 8) s5_unit(p, l, u, lds);
#endif
    }
    constexpr int NV_S5 = FAST_S5 ? 0 : 256, NV_RET = FAST_RET ? 0 : 64, NV = NV_S5 + NV_RET;
    if (NV > 0) {
        const int nfree = G > NW ? G - NW : G, fb = G > NW ? bx - NW : bx;
        if (fb >= 0) for (int u = wave * nfree + fb; u < NV; u += 8 * nfree) {
#if !FAST_S5
            if (u < NV_S5) { s5_simple(p, l, u); continue; }
#endif
#if !FAST_RET
            ret_simple(p, l, u - NV_S5);
#endif
        }
    }
}

__global__ void __launch_bounds__(512, 2) fwd_megakernel(Params p_arg) {
    extern __shared__ __attribute__((aligned(16))) unsigned char smem[];
    LAS unsigned char* lds = (LAS unsigned char*)smem;
    cg::grid_group grid = cg::this_grid();
    const int G = gridDim.x, bx = blockIdx.x;
    volatile LAS unsigned* xst = (volatile LAS unsigned*)(lds + LDS_BYTES - 16);
    if (threadIdx.x == 0) { xst[0] = 0u; xst[1] = 0u; }
    __syncthreads();
    const XcdBarrier xb = xcd_barrier_post((unsigned*)(fetch_params().ws + WS_BAR), xst);
    if (PHMASK & 1) { const Params p = fetch_params(); norm_phase<0, false>(p, nullptr, p.in[5]);
    convert_layer(p, 0, lds); }
    if (fetch_params().out == nullptr) grid.sync();
    GSYNC();
    for (int l_ = 0; l_ < NLAYERS_RUN; ++l_) {
        int l = l_; asm volatile("" : "+s"(l));
        if (PHMASK & 2) {
            const Params p = fetch_params(); const char* ws = (const char*)p.ws;
            pg8::PlainOrder S{ws + WS_U, ws + WS_WIN, 1024, 1024, 64, NPROJ / 256, G, bx};
            pg8::EpiProj E{p.ws};
            for (int rp = 0; rp < ((REPMASK & 2) ? 2 : 1); ++rp) { if (rp) GSYNC(); pg8::gemm_phase(lds, 1024, 1024, 1024, S, E); }
            meta_proj(p, lds);
        }
        GSYNC();
        { const Params p = fetch_params(); conv_phase(p, l); }
        GSYNC();
        if (PHMASK & 4) { const Params p = fetch_params(); mixer_phase(p, l, lds); }
        if (REPMASK & 4) { GSYNC(); const Params p = fetch_params(); mixer_phase(p, l, lds); }
        GSYNC();
        if (PHMASK & 8) {
            const Params p = fetch_params(); const char* ws = (const char*)p.ws;
            post_phase(p, l);
            pg8::PlainOrder S{ws + WS_S5P, ws + WS_WGLU, 512, 512, 64, 4, G, bx};
            pg8::EpiGlu E{(bf16_t*)(p.ws + WS_BR), p.in[21] + l * 1024};
            for (int rp = 0; rp < ((REPMASK & 8) ? 2 : 1); ++rp) { if (rp) GSYNC(); pg8::gemm_phase(lds, 512, 512, 512, S, E); }
            meta_glu(p, l, lds);
        }
        GSYNC();
        if (PHMASK & 16) {
            const Params p = fetch_params(); const char* ws = (const char*)p.ws;
            pg8::MergeOrder S{ws + WS_BR, ws + WS_WBR, 64, 4, G, bx};
            pg8::EpiMerge E{(bf16_t*)(p.ws + WS_MIXP), (const bf16_t*)(p.ws + WS_G)};
            for (int rp = 0; rp < ((REPMASK & 16) ? 2 : 1); ++rp) { if (rp) GSYNC(); pg8::gemm_phase(lds, LDBR, 512, 512, S, E); }
            meta_merge(p, lds);
        }
        GSYNC();
        if (PHMASK & 32) {
            const Params p = fetch_params(); const char* ws = (const char*)p.ws;
            pg8::PlainOrder S{ws + WS_MIXP, ws + WS_WOUT, 1024, 1024, 64, 4, G, bx};
            pg8::EpiBf E{(bf16_t*)(p.ws + WS_DELTA), 1024};
            for (int rp = 0; rp < ((REPMASK & 32) ? 2 : 1); ++rp) { if (rp) GSYNC(); pg8::gemm_phase(lds, 1024, 1024, 1024, S, E); }
            meta_f32(p, (const bf16_t*)(p.ws + WS_MIXP), 1024, (const bf16_t*)(p.ws + WS_WOUT), lds);
        }
        GSYNC();
        if (PHMASK & 64) { const Params p = fetch_params(); norm_phase<1, false>(p, p.in[6] + l * 1024, p.in[7] + l * 1024); }
        GSYNC();
        if (PHMASK & 128) {
            const Params p = fetch_params(); const char* ws = (const char*)p.ws;
            pg8::PlainOrder S{ws + WS_U, ws + WS_WUP, 1024, 1024, 64, 16, G, bx};
            pg8::EpiUp E{(bf16_t*)(p.ws + WS_G), DFF};
            for (int rp = 0; rp < ((REPMASK & 128) ? 2 : 1); ++rp) { if (rp) GSYNC(); pg8::gemm_phase(lds, 1024, 1024, 1024, S, E); }
            meta_up(p, lds);
        }
        GSYNC();
        if (PHMASK & 256) {
            const Params p = fetch_params(); const char* ws = (const char*)p.ws;
            pg8::PlainOrder S{ws + WS_G, ws + WS_WDN, DFF, DFF, 64, 4, G, bx};
            pg8::EpiBf E{(bf16_t*)(p.ws + WS_DELTA), 1024};
            for (int rp = 0; rp < ((REPMASK & 256) ? 2 : 1); ++rp) { if (rp) GSYNC(); pg8::gemm_phase(lds, DFF, DFF, DFF, S, E); }
            meta_f32(p, (const bf16_t*)(p.ws + WS_G), DFF, (const bf16_t*)(p.ws + WS_WDN), lds);
        }
        GSYNC();
        for (int sr = 0; sr < SYNCREP; ++sr) GSYNC();
        { const Params p = fetch_params();
        if (l + 1 < DEPTH) { norm_phase<1, false>(p, p.in[8] + l * 1024, p.in[5] + (l + 1) * 1024); convert_layer(p, l + 1, lds); GSYNC(); }
        else norm_phase<1, true>(p, p.in[8] + l * 1024, nullptr); }
    }
}

extern "C" void kernel_launch(void* const* d_in, const int* in_sizes, int n_in, void* d_out, int out_size, void* d_ws, size_t ws_size, hipStream_t stream) {
    static int grid_blocks = 0;
    if (grid_blocks == 0) {
        if (n_in != 30 || ws_size < WS_TOTAL) { fprintf(stderr, "kernel_launch: unexpected inputs (n_in %d, ws %zu, need %zu)\n", n_in, ws_size, (size_t)WS_TOTAL); grid_blocks = -1; return; }
        int dev = 0, cus = 0, per_cu = 0;
        hipGetDevice(&dev);
        hipDeviceGetAttribute(&cus, hipDeviceAttributeMultiprocessorCount, dev);
        if (hipFuncSetAttribute((const void*)fwd_megakernel, hipFuncAttributeMaxDynamicSharedMemorySize, LDS_BYTES) != hipSuccess) fprintf(stderr, "kernel_launch: hipFuncSetAttribute failed\n");
        hipOccupancyMaxActiveBlocksPerMultiprocessor(&per_cu, (const void*)fwd_megakernel, 512, LDS_BYTES);
        if (per_cu < 1) { fprintf(stderr, "kernel_launch: occupancy query says %d\n", per_cu); per_cu = 1; }
        (void)hipGetLastError();
        grid_blocks = cus * per_cu;
    }
    if (grid_blocks < 0) return;
    if (hipMemsetAsync((unsigned char*)d_ws + WS_BAR, 0, XCD_BAR_WORDS * 4, stream) != hipSuccess) { fprintf(stderr, "kernel_launch: memset of the barrier words failed\n"); return; }
    Params p{};
    for (int i = 0; i < 30; ++i) p.in[i] = (const float*)d_in[i];
    p.out = (float*)d_out; p.ws = (unsigned char*)d_ws;
    void* args[] = {&p};
    hipError_t e = hipLaunchCooperativeKernel((const void*)fwd_megakernel, dim3(grid_blocks), dim3(512), args, LDS_BYTES, stream);
    if (e != hipSuccess) fprintf(stderr, "cooperative launch failed: %s (grid %d)\n", hipGetErrorString(e), grid_blocks);
}
```

```cpp
#include <hip/hip_runtime.h>
#include <hip/hip_cooperative_groups.h>
#include <cstdio>
#include <cstdint>
namespace cg = cooperative_groups;

#define LAS __attribute__((address_space(3)))
typedef unsigned short bf16_t;
typedef short bf16x8 __attribute__((ext_vector_type(8)));
typedef float f32x4 __attribute__((ext_vector_type(4)));
typedef unsigned u32x4 __attribute__((ext_vector_type(4)));
typedef unsigned u32x2 __attribute__((ext_vector_type(2)));

#ifdef NOSYNC
#define GSYNC() __syncthreads()
#else
#define GSYNC() xcd_barrier(xb)
#endif
#ifndef NLAYERS_RUN
#define NLAYERS_RUN DEPTH
#endif
#ifndef EPIREP
#define EPIREP 0
#endif
#ifndef SYNCREP
#define SYNCREP 0
#endif
#ifndef MIXREP
#define MIXREP 0
#endif
#ifndef REPMASK
#define REPMASK 0
#endif
#ifndef PHMASK
#define PHMASK 0xFFFF
#endif
#ifndef FAST_RET
#define FAST_RET 1
#endif
#ifndef FAST_SSD
#define FAST_SSD 1
#endif
#ifndef FAST_HG
#define FAST_HG 1
#endif
#ifndef FAST_S5
#define FAST_S5 1
#endif

constexpr int NB = 8, SEQ = 2048, DM = 1024, DEPTH = 4, PADF = 48, TP = 2112  , MROWS = NB * TP  ;
constexpr int NPROJ = 9984, DFF = 4096, LDMX = 5632, LDG = 4096, LDDT = 256, LDBR = 2048;
constexpr float EPS = 1e-6f;
constexpr int RQ = 0, RK = 256, RV = 512, RG = 1024, S5U = 1536, SZ = 2048, SXBC = 2560, HQ = 3584, HF = 4096, HI = 4608, HGT = 5120;
constexpr size_t SZ_WIN = (size_t)NPROJ * 1024 * 2, SZ_WBR = (size_t)4 * 1024 * 512 * 2, SZ_WOUT = (size_t)1024 * 1024 * 2, SZ_WUP = (size_t)4096 * 1024 * 2, SZ_WDN = SZ_WUP, SZ_WGLU = (size_t)1024 * 512 * 2;
constexpr size_t WS_WIN = 0, WS_WBR = WS_WIN + SZ_WIN, WS_WOUT = WS_WBR + SZ_WBR, WS_WUP = WS_WOUT + SZ_WOUT, WS_WDN = WS_WUP + SZ_WUP, WS_WGLU = WS_WDN + SZ_WDN;
constexpr size_t WS_H = WS_WGLU + SZ_WGLU;
constexpr size_t WS_U = WS_H + (size_t)MROWS * 1024 * 4;
constexpr size_t WS_MX = WS_U + (size_t)MROWS * 1024 * 2;
constexpr size_t WS_G = WS_MX + (size_t)MROWS * LDMX * 2;
constexpr size_t WS_DT = WS_G + (size_t)MROWS * LDG * 2;
constexpr size_t WS_BR = WS_DT + (size_t)MROWS * LDDT * 2;
constexpr size_t WS_S5P = WS_BR + (size_t)MROWS * LDBR * 2;
constexpr size_t WS_END = WS_S5P + (size_t)MROWS * 512 * 2;
constexpr size_t WS_BAR = (WS_END + 255) & ~(size_t)255, WS_XBC = WS_BAR + 16384  , WS_TOTAL = WS_XBC + (size_t)MROWS * 1024 * 2;
constexpr size_t WS_MIXP = WS_MX;
constexpr size_t WS_DELTA = WS_MX + ((size_t)64 << 20);
static_assert(WS_DELTA + (size_t)MROWS * 1024 * 4 <= WS_G, "overlay");
constexpr int LDS_BYTES = 163840;

struct Params { const float* in[30]; float* out; unsigned char* ws; };
typedef const unsigned char __attribute__((address_space(4))) kbyte_t;
__device__ __forceinline__ Params fetch_params() {
#if defined(__HIP_DEVICE_COMPILE__)
    kbyte_t* k = (kbyte_t*)__builtin_amdgcn_kernarg_segment_ptr(); asm volatile("" : "+s"(k));
    typedef const unsigned long long __attribute__((address_space(4))) ku64_t;
    Params p;
#pragma unroll
    for (int i = 0; i < 30; ++i) p.in[i] = (const float*)(const float __attribute__((address_space(1)))*)((ku64_t*)k)[i];
    p.out = (float*)(float __attribute__((address_space(1)))*)((ku64_t*)k)[30]; p.ws = (unsigned char*)(unsigned char __attribute__((address_space(1)))*)((ku64_t*)k)[31];
    return p;
#else
    return Params{};
#endif
}

__device__ __forceinline__ int opaque_tid() { int t = threadIdx.x; asm volatile("" : "+v"(t)); return t; }
#define LDS_WAIT() asm volatile("s_waitcnt lgkmcnt(0)" ::: "memory")
#define LBAR() do { asm volatile("s_waitcnt lgkmcnt(0)" ::: "memory"); __builtin_amdgcn_s_barrier(); asm volatile("" ::: "memory"); } while (0)
typedef float f32x2_ __attribute__((ext_vector_type(2)));
typedef __bf16 bf16x2_ __attribute__((ext_vector_type(2)));
__device__ __forceinline__ unsigned pk2(float lo, float hi) { const f32x2_ v = {lo, hi}; return __builtin_bit_cast(unsigned, __builtin_convertvector(v, bf16x2_)); }
__device__ __forceinline__ unsigned f2bf(float f) { return (unsigned)__builtin_bit_cast(unsigned short, (__bf16)f); }
__device__ __forceinline__ float bf2f(unsigned b) { return __builtin_bit_cast(float, (b & 0xffffu) << 16); }
__device__ __forceinline__ float bflo(unsigned w) { return __builtin_bit_cast(float, w << 16); }
__device__ __forceinline__ float bfhi(unsigned w) { return __builtin_bit_cast(float, w & 0xffff0000u); }
__device__ __forceinline__ float wave_sum(float v) {
#pragma unroll
    for (int o = 1; o < 64; o <<= 1) v += __shfl_xor(v, o);
    return v;
}
__device__ __forceinline__ float sigmoidf_(float x) { return __builtin_amdgcn_rcpf(1.0f + __expf(-x)); }
__device__ __forceinline__ float siluf_(float x) { return x * __builtin_amdgcn_rcpf(1.0f + __expf(-x)); }
__device__ __forceinline__ float softplusf_(float x) { return x > 20.f ? x : log1pf(__expf(x)); }
__device__ __forceinline__ float geluf_(float x) { const float z = 0.7978845608f * (x + 0.044715f * x * x * x); const float e = __expf(2.f * z); const float th = 1.f - 2.f * __builtin_amdgcn_rcpf(e + 1.f); return 0.5f * x * (1.f + th); }
__device__ __forceinline__ void sincos_turns(float turns, float& s, float& c) { const float fr = turns - floorf(turns); s = __builtin_amdgcn_sinf(fr); c = __builtin_amdgcn_cosf(fr); }


__device__ __forceinline__ float gate_qf(float g) { return sigmoidf_(g) * 256.f - 0.5f; }
__device__ __forceinline__ unsigned gate_q8x4(float a, float b, float c, float d) {
    unsigned w = __builtin_amdgcn_cvt_pk_u8_f32(gate_qf(a), 0u, 0u); w = __builtin_amdgcn_cvt_pk_u8_f32(gate_qf(b), 1u, w); w = __builtin_amdgcn_cvt_pk_u8_f32(gate_qf(c), 2u, w); return __builtin_amdgcn_cvt_pk_u8_f32(gate_qf(d), 3u, w); }
__device__ __forceinline__ float gate_s(unsigned w, int byte) { return (float)((w >> (8 * byte)) & 255u) + 0.5f; }
#define XB_TMO      128
#define XB_XCNT(j)  (256  + 64 * (j))
#define XB_XSUB(j)  (1280 + 64 * (j))
#define XB_XGEN(j)  (2304 + 64 * (j))
#define XB_TOP      3328
#define XB_TOPGEN   3392
#define XCD_BAR_WORDS 3456
#define XB_SPIN_CAP (1u << 18)

__device__ __forceinline__ unsigned xb_ld(unsigned* p)              { return __hip_atomic_load(p, __ATOMIC_RELAXED, __HIP_MEMORY_SCOPE_AGENT); }
__device__ __forceinline__ unsigned xb_add(unsigned* p, unsigned v) { return __hip_atomic_fetch_add(p, v, __ATOMIC_RELAXED, __HIP_MEMORY_SCOPE_AGENT); }
__device__ __forceinline__ unsigned xb_xcc_id() { return (unsigned)__builtin_amdgcn_s_getreg((3 << 11) | 20) & 0xFu; }
#define XB_SPIN(cond, bar) do { unsigned _sp = 0; while (cond) { __builtin_amdgcn_s_sleep(1); \
    if ((++_sp & 255u) == 0u) { if (xb_ld(&(bar)[XB_TMO])) break; if (_sp > XB_SPIN_CAP) { atomicAdd(&(bar)[XB_TMO], 1u); break; } } } } while (0)

struct XcdBarrier {
    unsigned* bar; unsigned x;
    volatile LAS unsigned* st;
};

__device__ __forceinline__ XcdBarrier xcd_barrier_post(unsigned* bar, volatile LAS unsigned* st) {
    XcdBarrier b; b.bar = bar; b.x = xb_xcc_id(); b.st = st;
    if (threadIdx.x == 0) (void)xb_add(&bar[XB_XCNT(b.x)], 1u);
    return b;
}
__device__ __forceinline__ void xcd_barrier_complete(unsigned* bar, unsigned x, unsigned& nloc, unsigned& nx) {
    const unsigned G = gridDim.x * gridDim.y * gridDim.z;
    unsigned sum, cnt, mine, sp = 0u;
    for (;;) {
        sum = 0u; cnt = 0u; mine = 0u;
#pragma unroll
        for (unsigned j = 0; j < 16; ++j) { const unsigned c = xb_ld(&bar[XB_XCNT(j)]); sum += c; cnt += (c > 0u) ? 1u : 0u; mine = (j == x) ? c : mine; }
        if (sum == G) break;
        __builtin_amdgcn_s_sleep(1);
        if ((++sp & 255u) == 0u) { if (xb_ld(&bar[XB_TMO])) break; if (sp > XB_SPIN_CAP) { atomicAdd(&bar[XB_TMO], 1u); break; } }
    }
    nloc = mine > 0u ? mine : 1u; nx = cnt > 0u ? cnt : 1u;
}

__device__ __forceinline__ void xcd_barrier(const XcdBarrier& b) {
    asm volatile("s_waitcnt vmcnt(0)" ::: "memory");
    __syncthreads();
    if (threadIdx.x == 0) {
        unsigned* bar = b.bar;
        __builtin_amdgcn_s_waitcnt(0);
        unsigned nloc = b.st[0], nx = b.st[1];
        if (nloc == 0u) { xcd_barrier_complete(bar, b.x, nloc, nx); b.st[0] = nloc; b.st[1] = nx; }
        const unsigned old = xb_add(&bar[XB_XSUB(b.x)], 1u);
        const unsigned gen = old / nloc;
        if (old + 1u == (gen + 1u) * nloc) {
            __builtin_amdgcn_fence(__ATOMIC_RELEASE, "agent");
            asm volatile("s_waitcnt vmcnt(0)" ::: "memory");
            const unsigned og = xb_add(&bar[XB_TOP], 1u);
            const unsigned tg = og / nx;
            if (og + 1u == (tg + 1u) * nx) xb_add(&bar[XB_TOPGEN], 1u);
            else XB_SPIN(xb_ld(&bar[XB_TOPGEN]) == tg, bar);
            __builtin_amdgcn_fence(__ATOMIC_ACQUIRE, "agent");
            xb_add(&bar[XB_XGEN(b.x)], 1u);
            asm volatile("s_waitcnt vmcnt(0)" ::: "memory");
        } else {
            XB_SPIN(xb_ld(&bar[XB_XGEN(b.x)]) == gen, bar);
            __builtin_amdgcn_fence(__ATOMIC_ACQUIRE, "agent");
            asm volatile("s_waitcnt vmcnt(0)" ::: "memory");
        }
    }
    __syncthreads();
}


__device__ __forceinline__ void unpack8(const u32x4 w, float (&v)[8]);
namespace pg8 {
constexpr int BM = 256, BK = 64, HALF = 128, HTB = HALF * BK * 2, STAGE_BYTES = 8 * HTB, NXCD = 8, WGM = 8;
__device__ __forceinline__ int lds_byte(int r, int c) { const int st = (r >> 4) * 2 + (c >> 5), rr = r & 15, cc = c & 31, ob = rr * 64 + cc * 2; return st * 1024 + (ob ^ (((ob >> 9) & 1) << 5)); }
__device__ __forceinline__ void stage_rc(int b, int& R, int& C) { const int st = b / 1024, sb = b % 1024, swz = sb ^ (((sb >> 9) & 1) << 5); R = (st >> 1) * 16 + swz / 64; C = (st & 1) * 32 + (swz % 64) / 2; }
__device__ __forceinline__ int perm32(int rho) { const int n = rho >> 4, i = rho & 15; return 8 * (i >> 2) + 4 * n + (i & 3); }
struct Unit { int pm, pn, z, row0; const char* A; const char* B; };
__device__ __forceinline__ int tile_row0(int pm) { return (pm >> 3) * TP + 64 + (pm & 7) * 256; }
__device__ __forceinline__ void tile_of(int wgid, int nM, int nN, int& pm, int& pn) {
    const int nwg = nM * nN; { const int q = nwg / NXCD, r = nwg % NXCD, xcd = wgid % NXCD, off = wgid / NXCD; wgid = (xcd < r ? xcd * (q + 1) : r * (q + 1) + (xcd - r) * q) + off; }
    const int nig = WGM * nN, gid = wgid / nig, fm = gid * WGM, gsz = (nM - fm) < WGM ? (nM - fm) : WGM;
    pm = fm + ((wgid % nig) % gsz); pn = (wgid % nig) / gsz;
}
struct PlainOrder {
    const char* A; const char* B; int lda, ldb, nM, nN, G, c;
    __device__ __forceinline__ bool next(int i, Unit& u) const {
        const long L = (long)i * G + c; if (L >= (long)nM * nN) return false;
        tile_of((int)L, nM, nN, u.pm, u.pn); u.z = 0;
        u.row0 = tile_row0(u.pm); u.A = A + (size_t)u.row0 * lda * 2; u.B = B + (size_t)u.pn * 256 * ldb * 2; return true;
    }
};
struct MergeOrder {
    const char* A; const char* B; int nM, nN, G, c;
    __device__ __forceinline__ bool next(int i, Unit& u) const {
        const long L = (long)(i >> 2) * G + c; if (L >= (long)nM * nN) return false;
        tile_of((int)L, nM, nN, u.pm, u.pn); u.z = i & 3;
        u.row0 = tile_row0(u.pm); u.A = A + ((size_t)u.row0 * LDBR + (size_t)u.z * 512) * 2; u.B = B + ((size_t)u.z * 1024 * 512 + (size_t)u.pn * 256 * 512) * 2; return true;
    }
};
__device__ __forceinline__ unsigned cvt_pk_bf16(float lo, float hi) { return pk2(lo, hi); }

struct EpiF32 {
    static constexpr bool PERM = false, RMW = false, CHAIN = false;
    float* C; int ldc;
    __device__ __forceinline__ void operator()(const f32x4 (&acc)[2][2][4][2], const Unit& u, int wr, int wc, int fr, int fq) const {
        const int row0 = u.row0 + wr * 64 + fr, col0 = u.pn * BM + wc * 32 + 4 * fq;
#pragma unroll
        for (int ai = 0; ai < 2; ++ai)
#pragma unroll
            for (int m = 0; m < 4; ++m) { float* rowp = C + (size_t)(row0 + ai * HALF + m * 16) * ldc + col0;
#pragma unroll
                for (int bj = 0; bj < 2; ++bj)
#pragma unroll
                    for (int n = 0; n < 2; ++n) *(f32x4*)(rowp + bj * HALF + n * 16) = acc[ai][bj][m][n]; }
    }
};
struct EpiProj {
    static constexpr bool PERM = true, RMW = false, CHAIN = false;
    unsigned char* ws;
    __device__ __forceinline__ void operator()(const f32x4 (&acc)[2][2][4][2], const Unit& u, int wr, int wc, int fr, int fq) const {
        bf16_t* const MX = (bf16_t*)(ws + WS_MX); unsigned char* const G = ws + WS_G; bf16_t* const DT = (bf16_t*)(ws + WS_DT);
        bf16_t* base; int ldc, colt;
        const bool isg = u.pn >= 22 && u.pn < 38;
        if (u.pn < 22) { base = MX; ldc = LDMX; colt = u.pn * 256; } else { base = DT; ldc = LDDT; colt = isg ? (u.pn - 22) * 256 : 0; }
        const int row0 = u.row0 + wr * 64 + fr, col0 = colt + wc * 32 + 8 * fq;
        if (isg) {
            unsigned char* G8 = G;
#pragma unroll
            for (int ai = 0; ai < 2; ++ai)
#pragma unroll
                for (int m = 0; m < 4; ++m) { unsigned char* rowp = G8 + (size_t)(row0 + ai * HALF + m * 16) * LDG + col0;
#pragma unroll
                    for (int bj = 0; bj < 2; ++bj) { const f32x4 v0 = acc[ai][bj][m][0], v1 = acc[ai][bj][m][1];
                        *(u32x2*)(rowp + bj * HALF) = (u32x2){gate_q8x4(v0[0], v0[1], v0[2], v0[3]), gate_q8x4(v1[0], v1[1], v1[2], v1[3])}; } }
        } else {
#pragma unroll
        for (int ai = 0; ai < 2; ++ai)
#pragma unroll
            for (int m = 0; m < 4; ++m) { bf16_t* rowp = base + (size_t)(row0 + ai * HALF + m * 16) * ldc + col0;
#pragma unroll
                for (int bj = 0; bj < 2; ++bj) { const f32x4 v0 = acc[ai][bj][m][0], v1 = acc[ai][bj][m][1];
                    u32x4 w; w.x = cvt_pk_bf16(v0[0], v0[1]); w.y = cvt_pk_bf16(v0[2], v0[3]); w.z = cvt_pk_bf16(v1[0], v1[1]); w.w = cvt_pk_bf16(v1[2], v1[3]);
                    *(u32x4*)(rowp + bj * HALF) = w; } }
        }
    }
};
struct EpiBf {
    static constexpr bool PERM = true, RMW = false, CHAIN = false;
    bf16_t* O; int ldc;
    __device__ __forceinline__ void operator()(const f32x4 (&acc)[2][2][4][2], const Unit& u, int wr, int wc, int fr, int fq) const {
        const int row0 = u.row0 + wr * 64 + fr, col0 = u.pn * BM + wc * 32 + 8 * fq;
#pragma unroll
        for (int ai = 0; ai < 2; ++ai)
#pragma unroll
            for (int m = 0; m < 4; ++m) { bf16_t* rowp = O + (size_t)(row0 + ai * HALF + m * 16) * ldc + col0;
#pragma unroll
                for (int bj = 0; bj < 2; ++bj) { const f32x4 v0 = acc[ai][bj][m][0], v1 = acc[ai][bj][m][1];
                    u32x4 w; w.x = cvt_pk_bf16(v0[0], v0[1]); w.y = cvt_pk_bf16(v0[2], v0[3]); w.z = cvt_pk_bf16(v1[0], v1[1]); w.w = cvt_pk_bf16(v1[2], v1[3]);
                    *(u32x4*)(rowp + bj * HALF) = w; } }
    }
};
struct EpiUp {
    static constexpr bool PERM = true, RMW = false, CHAIN = false;
    bf16_t* O; int ldc;
    __device__ __forceinline__ void operator()(const f32x4 (&acc)[2][2][4][2], const Unit& u, int wr, int wc, int fr, int fq) const {
        const int row0 = u.row0 + wr * 64 + fr, col0 = u.pn * BM + wc * 32 + 8 * fq;
#pragma unroll
        for (int ai = 0; ai < 2; ++ai)
#pragma unroll
            for (int m = 0; m < 4; ++m) { bf16_t* rowp = O + (size_t)(row0 + ai * HALF + m * 16) * ldc + col0;
#pragma unroll
                for (int bj = 0; bj < 2; ++bj) { f32x4 v0 = acc[ai][bj][m][0], v1 = acc[ai][bj][m][1];
#pragma unroll
                    for (int j = 0; j < 4; ++j) { const float a = fmaxf(v0[j], 0.f), b = fmaxf(v1[j], 0.f); v0[j] = a * a; v1[j] = b * b; }
                    u32x4 w; w.x = cvt_pk_bf16(v0[0], v0[1]); w.y = cvt_pk_bf16(v0[2], v0[3]); w.z = cvt_pk_bf16(v1[0], v1[1]); w.w = cvt_pk_bf16(v1[2], v1[3]);
                    *(u32x4*)(rowp + bj * HALF) = w; } }
    }
};
struct EpiGlu {
    static constexpr bool PERM = true, RMW = false, CHAIN = false;
    bf16_t* BR; const float* bias;
    __device__ __forceinline__ void operator()(const f32x4 (&acc)[2][2][4][2], const Unit& u, int wr, int wc, int fr, int fq) const {
        const int row0 = u.row0 + wr * 64 + fr, oc = u.pn * 128 + wc * 32 + 8 * fq;
        const f32x4 ba0 = *(const f32x4*)(bias + oc), ba1 = *(const f32x4*)(bias + oc + 4), bg0 = *(const f32x4*)(bias + 512 + oc), bg1 = *(const f32x4*)(bias + 512 + oc + 4);
#pragma unroll
        for (int ai = 0; ai < 2; ++ai)
#pragma unroll
            for (int m = 0; m < 4; ++m) { bf16_t* rowp = BR + (size_t)(row0 + ai * HALF + m * 16) * LDBR + 512 + oc;
                f32x4 a0 = acc[ai][0][m][0] + ba0, a1 = acc[ai][0][m][1] + ba1; const f32x4 g0 = acc[ai][1][m][0] + bg0, g1 = acc[ai][1][m][1] + bg1;
#pragma unroll
                for (int j = 0; j < 4; ++j) { a0[j] = a0[j] * sigmoidf_(g0[j]); a1[j] = a1[j] * sigmoidf_(g1[j]); }
                u32x4 w; w.x = cvt_pk_bf16(a0[0], a0[1]); w.y = cvt_pk_bf16(a0[2], a0[3]); w.z = cvt_pk_bf16(a1[0], a1[1]); w.w = cvt_pk_bf16(a1[2], a1[3]);
                *(u32x4*)rowp = w; }
    }
};
struct EpiMerge {
    static constexpr bool PERM = true, RMW = true, CHAIN = true;
    bf16_t* O; const bf16_t* G;
    __device__ __forceinline__ void operator()(f32x4 (&acc)[2][2][4][2], const Unit& u, int wr, int wc, int fr, int fq) const {
        const int row0 = u.row0 + wr * 64 + fr, col0 = u.pn * BM + wc * 32 + 8 * fq;
        const unsigned char* G8 = (const unsigned char*)G;
        if (u.z < 3) {
#pragma unroll
            for (int ai = 0; ai < 2; ++ai)
#pragma unroll
                for (int m = 0; m < 4; ++m) { const size_t row = (size_t)(row0 + ai * HALF + m * 16);
#pragma unroll
                    for (int bj = 0; bj < 2; ++bj) { const int col = col0 + bj * HALF;
                        const u32x2 ga = *(const u32x2*)(G8 + row * LDG + u.z * 1024 + col), gb = *(const u32x2*)(G8 + row * LDG + (u.z + 1) * 1024 + col);
                        { f32x4 r0, r1;
                          r0[0] = gate_s(ga.x, 0) * __builtin_amdgcn_rcpf(gate_s(gb.x, 0)); r0[1] = gate_s(ga.x, 1) * __builtin_amdgcn_rcpf(gate_s(gb.x, 1)); r0[2] = gate_s(ga.x, 2) * __builtin_amdgcn_rcpf(gate_s(gb.x, 2)); r0[3] = gate_s(ga.x, 3) * __builtin_amdgcn_rcpf(gate_s(gb.x, 3));
                          r1[0] = gate_s(ga.y, 0) * __builtin_amdgcn_rcpf(gate_s(gb.y, 0)); r1[1] = gate_s(ga.y, 1) * __builtin_amdgcn_rcpf(gate_s(gb.y, 1)); r1[2] = gate_s(ga.y, 2) * __builtin_amdgcn_rcpf(gate_s(gb.y, 2)); r1[3] = gate_s(ga.y, 3) * __builtin_amdgcn_rcpf(gate_s(gb.y, 3));
                          acc[ai][bj][m][0] = acc[ai][bj][m][0] * r0; acc[ai][bj][m][1] = acc[ai][bj][m][1] * r1; } } }
        } else {
#pragma unroll
            for (int ai = 0; ai < 2; ++ai)
#pragma unroll
                for (int m = 0; m < 4; ++m) { const size_t row = (size_t)(row0 + ai * HALF + m * 16);
#pragma unroll
                    for (int bj = 0; bj < 2; ++bj) { const int col = col0 + bj * HALF;
                        const u32x2 gw = *(const u32x2*)(G8 + row * LDG + 3 * 1024 + col);
                        f32x4 v0 = acc[ai][bj][m][0], v1 = acc[ai][bj][m][1];
                        v0 = v0 * (f32x4){gate_s(gw.x, 0), gate_s(gw.x, 1), gate_s(gw.x, 2), gate_s(gw.x, 3)} * (1.f / 256.f); v1 = v1 * (f32x4){gate_s(gw.y, 0), gate_s(gw.y, 1), gate_s(gw.y, 2), gate_s(gw.y, 3)} * (1.f / 256.f);
                        u32x4 w; w.x = cvt_pk_bf16(v0[0], v0[1]); w.y = cvt_pk_bf16(v0[2], v0[3]); w.z = cvt_pk_bf16(v1[0], v1[1]); w.w = cvt_pk_bf16(v1[2], v1[3]);
                        *(u32x4*)(O + row * 1024 + col) = w; } }
        }
    }
};

template <class Epi, class Sched>
__device__ __forceinline__ void gemm_phase(LAS unsigned char* lds, const int lda, const int ldb, const int K, const Sched& S, const Epi& E) {
    int tid_ = threadIdx.x; asm volatile("" : "+v"(tid_));
    const int tid = tid_, wid = __builtin_amdgcn_readfirstlane(tid >> 6), lane = tid & 63, wr = wid >> 2, wc = wid & 3, fr = lane & 15, fq = lane >> 4;
    const int nt = K / BK;
    unsigned voffA[2], voffB[2];
#pragma unroll
    for (int i = 0; i < 2; ++i) { int R, C; stage_rc(tid * 16 + i * 8192, R, C); const int Rb = Epi::PERM ? ((R & ~31) + perm32(R & 31)) : R;
        voffA[i] = (unsigned)(R * lda + C) * 2u; voffB[i] = (unsigned)(Rb * ldb + C) * 2u; }
    const size_t kstep = (size_t)(BK * 2);
    const size_t hstepA = (size_t)HALF * lda * 2, hstepB = (size_t)HALF * ldb * 2;
    const unsigned ldsw = (unsigned)wid * 1024u;
    const int aoff = lds_byte(wr * 64 + fr, fq * 8), boff = lds_byte(wc * 32 + fr, fq * 8);
#define PG8_SA(b, h) (((b) * 2 + (h)) * HTB)
#define PG8_SB(b, h) ((4 + (b) * 2 + (h)) * HTB)
#define PG8_STAGE(bufoff, gbase, voff) do { _Pragma("unroll") for (int _i = 0; _i < 2; ++_i) \
        __builtin_amdgcn_global_load_lds((const unsigned*)((const char*)(gbase) + (voff)[_i]), (LAS unsigned*)(lds + (bufoff) + ldsw + _i * 8192), 16, 0, 0); } while (0)
#define PG8_LDA(dst, b, h) do { _Pragma("unroll") for (int m = 0; m < 4; ++m) _Pragma("unroll") for (int k = 0; k < 2; ++k) dst[m][k] = *(const LAS bf16x8*)(lds + PG8_SA(b, h) + aoff + m * 2048 + k * 1024); } while (0)
#define PG8_LDB(dst, b, h) do { _Pragma("unroll") for (int n = 0; n < 2; ++n) _Pragma("unroll") for (int k = 0; k < 2; ++k) dst[n][k] = *(const LAS bf16x8*)(lds + PG8_SB(b, h) + boff + n * 2048 + k * 1024); } while (0)
#define PG8_MMA(ai, bj, At, Bt) do { __builtin_amdgcn_s_setprio(1); _Pragma("unroll") for (int m = 0; m < 4; ++m) _Pragma("unroll") for (int n = 0; n < 2; ++n) _Pragma("unroll") for (int k = 0; k < 2; ++k) \
        acc[ai][bj][m][n] = __builtin_amdgcn_mfma_f32_16x16x32_bf16(Bt[n][k], At[m][k], acc[ai][bj][m][n], 0, 0, 0); __builtin_amdgcn_s_setprio(0); } while (0)
#define PG8_WAIT_V(n) asm volatile("s_waitcnt vmcnt(" #n ")" ::: "memory")
#define PG8_WAIT_L(n) asm volatile("s_waitcnt lgkmcnt(" #n ")" ::: "memory")
#define PG8_BAR __builtin_amdgcn_s_barrier()
#define PG8_SCHED __builtin_amdgcn_sched_barrier(0)
    Unit cur, nxt; int ui = 0;
    if (!S.next(0, cur)) return;
    f32x4 acc[2][2][4][2];
#pragma unroll
    for (int a = 0; a < 2; ++a)
#pragma unroll
        for (int b = 0; b < 2; ++b)
#pragma unroll
            for (int m = 0; m < 4; ++m)
#pragma unroll
                for (int n = 0; n < 2; ++n) acc[a][b][m][n] = (f32x4){0.f, 0.f, 0.f, 0.f};
    bf16x8 At[4][2], B0[2][2], B1[2][2];
    const char* cA = cur.A; const char* cB = cur.B;
    PG8_STAGE(PG8_SB(0, 0), cB, voffB); PG8_STAGE(PG8_SB(0, 1), cB + hstepB, voffB); PG8_STAGE(PG8_SA(0, 0), cA, voffA); PG8_STAGE(PG8_SA(0, 1), cA + hstepA, voffA);
    if (wr == 1) PG8_BAR;
    PG8_WAIT_V(2); PG8_BAR;
    PG8_STAGE(PG8_SB(1, 0), cB + kstep, voffB); PG8_STAGE(PG8_SA(1, 0), cA + kstep, voffA); PG8_STAGE(PG8_SB(1, 1), cB + hstepB + kstep, voffB);
    PG8_WAIT_V(6); PG8_BAR;
    for (;;) {
        const bool has_next = S.next(ui + 1, nxt);
        const char* nA = has_next ? nxt.A : cA; const char* nB = has_next ? nxt.B : cB;
        for (int t = 0; t < nt; t += 2) {
            const bool last = (t == nt - 2);
            const char* a1 = cA + (size_t)(t + 1) * kstep;
            const char* a2 = last ? nA : cA + (size_t)(t + 2) * kstep; const char* b2 = last ? nB : cB + (size_t)(t + 2) * kstep;
            const char* a3 = a2 + kstep; const char* b3 = b2 + kstep;
            PG8_LDB(B0, 0, 0); PG8_LDB(B1, 0, 1); PG8_SCHED; PG8_LDA(At, 0, 0); PG8_STAGE(PG8_SA(1, 1), a1 + hstepA, voffA);
            PG8_WAIT_V(8); PG8_WAIT_L(0); PG8_BAR; PG8_MMA(0, 0, At, B0); PG8_MMA(0, 1, At, B1); PG8_BAR; PG8_SCHED;
            PG8_LDA(At, 0, 1); PG8_STAGE(PG8_SB(0, 0), b2, voffB); PG8_STAGE(PG8_SB(0, 1), b2 + hstepB, voffB); PG8_STAGE(PG8_SA(0, 0), a2, voffA);
            PG8_WAIT_V(8); PG8_WAIT_L(0); PG8_BAR; PG8_MMA(1, 0, At, B0); PG8_MMA(1, 1, At, B1); PG8_BAR; PG8_SCHED;
            PG8_LDB(B0, 1, 0); PG8_LDB(B1, 1, 1); PG8_SCHED; PG8_LDA(At, 1, 0); PG8_STAGE(PG8_SA(0, 1), a2 + hstepA, voffA);
            PG8_WAIT_V(8); PG8_WAIT_L(0); PG8_BAR; PG8_MMA(0, 0, At, B0); PG8_MMA(0, 1, At, B1); PG8_BAR; PG8_SCHED;
            PG8_LDA(At, 1, 1); PG8_STAGE(PG8_SB(1, 0), b3, voffB); PG8_STAGE(PG8_SB(1, 1), b3 + hstepB, voffB); PG8_STAGE(PG8_SA(1, 0), a3, voffA);
            PG8_WAIT_V(8); PG8_WAIT_L(0); PG8_BAR; PG8_MMA(1, 0, At, B0); PG8_MMA(1, 1, At, B1); PG8_BAR; PG8_SCHED;
        }
        if (wr == 0) PG8_BAR;
        E(acc, cur, wr, wc, fr, fq);
        if (EPIREP && !Epi::RMW) { asm volatile("" ::: "memory"); E(acc, cur, wr, wc, fr, fq); }
        if (!has_next) break;
        if (!(Epi::CHAIN && cur.z < 3)) {
#pragma unroll
        for (int a = 0; a < 2; ++a)
#pragma unroll
            for (int b = 0; b < 2; ++b)
#pragma unroll
                for (int m = 0; m < 4; ++m)
#pragma unroll
                    for (int n = 0; n < 2; ++n) acc[a][b][m][n] = (f32x4){0.f, 0.f, 0.f, 0.f};
        }
        cur = nxt; cA = nA; cB = nB; ++ui;
        if (wr == 1) PG8_BAR;
    }
    PG8_WAIT_V(0);
    PG8_BAR;
#undef PG8_SA
#undef PG8_SB
#undef PG8_STAGE
#undef PG8_LDA
#undef PG8_LDB
#undef PG8_MMA
#undef PG8_WAIT_V
#undef PG8_WAIT_L
#undef PG8_BAR
#undef PG8_SCHED
}
}

template <int MODE> __device__ __forceinline__ int colmap(int n) {
    if (MODE == 1) { if (n < 3584) return n; if (n < 9728) return n + 8; if (n < 9736) return 3584 + (n - 9728); return -1; }
    if (MODE == 2) { const int pn = n >> 8, bj = (n >> 7) & 1, i = n & 127; return bj * 512 + pn * 128 + i; }
    return n;
}
struct TrItem { const float* W; bf16_t* WT; int K, Nsrc, mode, k0, n0; };
__device__ __forceinline__ int colmap_rt(int mode, int n) { return mode == 1 ? colmap<1>(n) : (mode == 2 ? colmap<2>(n) : n); }
__device__ __forceinline__ TrItem tr_decode(const Params& p, int l, int it) {
    constexpr int I_IN = 16 * (NPROJ / 32), I_BR1 = 8 * 32, I_OUT = 16 * 32, I_UP = 16 * 128, I_DN = 64 * 32;
    TrItem t; int r = it, Ndst;
    if (r < I_IN) { t.W = p.in[2] + (size_t)l * 1024 * 9736; t.WT = (bf16_t*)(p.ws + WS_WIN); t.K = 1024; t.Nsrc = 9736; Ndst = NPROJ; t.mode = 1; }
    else if ((r -= I_IN) < 4 * I_BR1) { const int n = r / I_BR1; r -= n * I_BR1; t.W = p.in[3] + ((size_t)l * 4 + n) * 512 * 1024; t.WT = (bf16_t*)(p.ws + WS_WBR) + (size_t)n * 1024 * 512; t.K = 512; t.Nsrc = 1024; Ndst = 1024; t.mode = 0; }
    else if ((r -= 4 * I_BR1) < I_OUT) { t.W = p.in[4] + (size_t)l * 1024 * 1024; t.WT = (bf16_t*)(p.ws + WS_WOUT); t.K = 1024; t.Nsrc = 1024; Ndst = 1024; t.mode = 0; }
    else if ((r -= I_OUT) < I_UP) { t.W = p.in[9] + (size_t)l * 1024 * 4096; t.WT = (bf16_t*)(p.ws + WS_WUP); t.K = 1024; t.Nsrc = 4096; Ndst = 4096; t.mode = 0; }
    else if ((r -= I_UP) < I_DN) { t.W = p.in[10] + (size_t)l * 4096 * 1024; t.WT = (bf16_t*)(p.ws + WS_WDN); t.K = 4096; t.Nsrc = 1024; Ndst = 1024; t.mode = 0; }
    else { r -= I_DN; t.W = p.in[20] + (size_t)l * 512 * 1024; t.WT = (bf16_t*)(p.ws + WS_WGLU); t.K = 512; t.Nsrc = 1024; Ndst = 1024; t.mode = 2; }
    const int nblk = Ndst / 32, kb = r / nblk, nb = r - kb * nblk; t.k0 = 64 * kb; t.n0 = 32 * nb;
    return t;
}
__device__ __forceinline__ void tr_load(const TrItem& t, int lane, float (&v)[32]) {
    const int sc = colmap_rt(t.mode, t.n0 + (lane & 31));
    const float* src = t.W + (size_t)(t.k0 + (lane >> 5)) * t.Nsrc + (sc >= 0 ? sc : 0);
#pragma unroll
    for (int i = 0; i < 32; ++i) { const float x = src[(size_t)(2 * i) * t.Nsrc]; v[i] = sc >= 0 ? x : 0.f; }
}
__device__ __forceinline__ void convert_layer(const Params& p, int l, LAS unsigned char* lds) {
    const int tid__ = opaque_tid(); const int lane = tid__ & 63, wave = tid__ >> 6;
    LAS float* scr = (LAS float*)(lds + wave * 8448);
    const int gw = blockIdx.x * 8 + wave, NGW = gridDim.x * 8;
    constexpr int NIT = 16 * (NPROJ / 32) + 4 * 8 * 32 + 16 * 32 + 16 * 128 + 64 * 32 + 8 * 32;
    float v[32]; TrItem cur{};
    int it = gw;
    if (it < NIT) { cur = tr_decode(p, l, it); tr_load(cur, lane, v); }
    while (it < NIT) {
        const TrItem done = cur;
#pragma unroll
        for (int i = 0; i < 32; ++i) scr[(2 * i + (lane >> 5)) * 33 + (lane & 31)] = v[i];
        const int nxt = it + NGW;
        if (nxt < NIT) { cur = tr_decode(p, l, nxt); tr_load(cur, lane, v); }
        LDS_WAIT();
        const int c = lane & 7;
#pragma unroll
        for (int j = 0; j < 4; ++j) { const int n = (lane >> 3) + 8 * j; const LAS float* sp = scr + (8 * c) * 33 + n;
            u32x4 o; o.x = pk2(sp[0 * 33], sp[1 * 33]); o.y = pk2(sp[2 * 33], sp[3 * 33]); o.z = pk2(sp[4 * 33], sp[5 * 33]); o.w = pk2(sp[6 * 33], sp[7 * 33]);
            *(u32x4*)(done.WT + (size_t)(done.n0 + n) * done.K + done.k0 + 8 * c) = o; }
        LDS_WAIT();
        it = nxt;
    }
}

template <int MODE, bool FINAL> __device__ __forceinline__ void norm_phase(const Params& p, const float* wpost, const float* wpre) {
    const int tid__ = opaque_tid(); const int lane = tid__ & 63, wave = tid__ >> 6;
    const int gw = blockIdx.x * 8 + wave, NGW = gridDim.x * 8;
    float* H = (float*)(p.ws + WS_H); const bf16_t* DL = (const bf16_t*)(p.ws + WS_DELTA); bf16_t* U = (bf16_t*)(p.ws + WS_U);
    f32x4 hn[4]; u32x2 dn[4];
    auto src_of = [&](int row) -> const float* { const int b = row / TP, r = row - b * TP;
        if (MODE == 0) return r < 64 ? p.in[1] + (size_t)(r < PADF ? 0 : r - PADF) * 1024 : p.in[0] + ((size_t)b * SEQ + (r - 64)) * 1024;
        return H + (size_t)row * 1024; };
    auto load_row = [&](int row) { const float* src = src_of(row);
#pragma unroll
        for (int j = 0; j < 4; ++j) { hn[j] = *(const f32x4*)(src + 4 * lane + 256 * j); if (MODE == 1) dn[j] = *(const u32x2*)(DL + (size_t)row * 1024 + 4 * lane + 256 * j); } };
    if (gw < MROWS) load_row(gw);
    for (int row = gw; row < MROWS; row += NGW) {
        const int b = row / TP, r = row - b * TP; const bool pad = r < PADF;
        f32x4 hv[4], dv[4];
#pragma unroll
        for (int j = 0; j < 4; ++j) { hv[j] = hn[j]; if (MODE == 1) dv[j] = (f32x4){bflo(dn[j].x), bfhi(dn[j].x), bflo(dn[j].y), bfhi(dn[j].y)}; }
        if (row + NGW < MROWS) load_row(row + NGW);
        if (MODE == 0) {
#pragma unroll
            for (int j = 0; j < 4; ++j) if (pad) hv[j] = (f32x4){0.f, 0.f, 0.f, 0.f};
        } else {
            float ss = 0.f;
#pragma unroll
            for (int j = 0; j < 4; ++j) ss += (dv[j][0] * dv[j][0] + dv[j][1] * dv[j][1]) + (dv[j][2] * dv[j][2] + dv[j][3] * dv[j][3]);
            const float rstd = rsqrtf(wave_sum(ss) * (1.f / 1024.f) + EPS);
#pragma unroll
            for (int j = 0; j < 4; ++j) { const f32x4 w = *(const f32x4*)(wpost + 4 * lane + 256 * j); hv[j] = hv[j] + dv[j] * rstd * w; if (pad) hv[j] = (f32x4){0.f, 0.f, 0.f, 0.f}; }
        }
        if (FINAL) {
            if (r >= 64) {
#pragma unroll
                for (int j = 0; j < 4; ++j) *(f32x4*)(p.out + ((size_t)b * SEQ + (r - 64)) * 1024 + 4 * lane + 256 * j) = hv[j];
            }
        } else {
            float ss = 0.f;
#pragma unroll
            for (int j = 0; j < 4; ++j) { *(f32x4*)(H + (size_t)row * 1024 + 4 * lane + 256 * j) = hv[j]; ss += (hv[j][0] * hv[j][0] + hv[j][1] * hv[j][1]) + (hv[j][2] * hv[j][2] + hv[j][3] * hv[j][3]); }
            const float rstd = rsqrtf(wave_sum(ss) * (1.f / 1024.f) + EPS);
#pragma unroll
            for (int j = 0; j < 4; ++j) { const f32x4 w = *(const f32x4*)(wpre + 4 * lane + 256 * j); const f32x4 o = hv[j] * rstd * w;
                u32x2 q; q.x = pk2(o[0], o[1]); q.y = pk2(o[2], o[3]); *(u32x2*)(U + (size_t)row * 1024 + 4 * lane + 256 * j) = q; }
        }
    }
}

__device__ __forceinline__ void unpack8(const u32x4 w, float (&v)[8]) { v[0] = bflo(w.x); v[1] = bfhi(w.x); v[2] = bflo(w.y); v[3] = bfhi(w.y); v[4] = bflo(w.z); v[5] = bfhi(w.z); v[6] = bflo(w.w); v[7] = bfhi(w.w); }
__device__ __forceinline__ u32x4 pack8(const float (&v)[8]) { u32x4 w; w.x = pk2(v[0], v[1]); w.y = pk2(v[2], v[3]); w.z = pk2(v[4], v[5]); w.w = pk2(v[6], v[7]); return w; }
__device__ __forceinline__ void post_phase(const Params& p, int l) {
    const int tid__ = opaque_tid(); const int lane = tid__ & 63, wave = tid__ >> 6;
    const int gw = blockIdx.x * 8 + wave, NGW = gridDim.x * 8;
    bf16_t* BR = (bf16_t*)(p.ws + WS_BR); const bf16_t* MX = (const bf16_t*)(p.ws + WS_MX);
    const float* gnw = p.in[11] + l * 512 + lane * 8; const float* ssdw = p.in[27] + l * 512 + lane * 8; const float* hgw = p.in[29] + l * 512 + lane * 8;
    u32x4 n0, n1, n2, n3, n4;
    auto load_row = [&](int row) { const bf16_t* br = BR + (size_t)row * LDBR + lane * 8; const bf16_t* mx = MX + (size_t)row * LDMX + lane * 8;
        n0 = *(const u32x4*)br; n1 = *(const u32x4*)(mx + RG); n2 = *(const u32x4*)(br + 1024); n3 = *(const u32x4*)(br + 1536); n4 = *(const u32x4*)(mx + HGT); };
    if (gw < MROWS) load_row(gw);
    for (int row = gw; row < MROWS; row += NGW) {
        bf16_t* br = BR + (size_t)row * LDBR + lane * 8;
        const u32x4 c0 = n0, c1 = n1, c2 = n2, c3 = n3, c4 = n4;
        if (row + NGW < MROWS) load_row(row + NGW);
        float y[8], g[8];
        {
            unpack8(c0, y); unpack8(c1, g);
            float s = 0.f;
#pragma unroll
            for (int j = 0; j < 8; ++j) s += y[j];
            s += __shfl_xor(s, 1); s += __shfl_xor(s, 2); s += __shfl_xor(s, 4); s += __shfl_xor(s, 8);
            const float mu = s * (1.f / 128.f); float v = 0.f;
#pragma unroll
            for (int j = 0; j < 8; ++j) { y[j] -= mu; v += y[j] * y[j]; }
            v += __shfl_xor(v, 1); v += __shfl_xor(v, 2); v += __shfl_xor(v, 4); v += __shfl_xor(v, 8);
            const float rstd = rsqrtf(v * (1.f / 128.f) + EPS);
#pragma unroll
            for (int j = 0; j < 8; ++j) y[j] = siluf_(g[j]) * (y[j] * rstd * gnw[j]);
            *(u32x4*)br = pack8(y);
        }
        {
            unpack8(c2, y);
            float v = 0.f;
#pragma unroll
            for (int j = 0; j < 8; ++j) v += y[j] * y[j];
            v += __shfl_xor(v, 1); v += __shfl_xor(v, 2); v += __shfl_xor(v, 4); v += __shfl_xor(v, 8); v += __shfl_xor(v, 16);
            const float rstd = rsqrtf(v * (1.f / 256.f) + EPS);
#pragma unroll
            for (int j = 0; j < 8; ++j) y[j] = y[j] * rstd * ssdw[j];
            *(u32x4*)(br + 1024) = pack8(y);
        }
        {
            unpack8(c3, y); unpack8(c4, g);
            float v = 0.f;
#pragma unroll
            for (int j = 0; j < 8; ++j) v += y[j] * y[j];
            v += __shfl_xor(v, 1); v += __shfl_xor(v, 2); v += __shfl_xor(v, 4); v += __shfl_xor(v, 8);
            const float rstd = rsqrtf(v * (1.f / 128.f) + EPS);
#pragma unroll
            for (int j = 0; j < 8; ++j) y[j] = y[j] * rstd * hgw[j] * siluf_(g[j]);
            *(u32x4*)(br + 1536) = pack8(y);
        }
    }
}

__device__ __forceinline__ void conv_phase(const Params& p, int l) {
    const int tid = opaque_tid();
    const bf16_t* MX = (const bf16_t*)(p.ws + WS_MX); bf16_t* XBC = (bf16_t*)(p.ws + WS_XBC);
    const int NT = NB * (TP / 8) * 128;
    for (int task = blockIdx.x * 512 + tid; task < NT; task += gridDim.x * 512) {
        const int cg8 = task & 127, rb = (task >> 7) % (TP / 8), b = (task >> 7) / (TP / 8), ch0 = cg8 * 8, r0 = rb * 8;
        if (b > 0 && r0 < 64) continue;
        bf16_t* dst = XBC + ((size_t)b * TP + r0) * 1024 + ch0;
        if (r0 < PADF) {
#pragma unroll
            for (int i = 0; i < 8; ++i) *(u32x4*)(dst + (size_t)i * 1024) = (u32x4){0u, 0u, 0u, 0u};
            continue; }
        float cw[4][8], cb[8], win[3][8];
#pragma unroll
        for (int j = 0; j < 4; ++j) { const f32x4 x0 = *(const f32x4*)(p.in[22] + (size_t)(l * 4 + j) * 1024 + ch0), x1 = *(const f32x4*)(p.in[22] + (size_t)(l * 4 + j) * 1024 + ch0 + 4);
            cw[j][0] = x0[0]; cw[j][1] = x0[1]; cw[j][2] = x0[2]; cw[j][3] = x0[3]; cw[j][4] = x1[0]; cw[j][5] = x1[1]; cw[j][6] = x1[2]; cw[j][7] = x1[3]; }
        { const f32x4 x0 = *(const f32x4*)(p.in[23] + l * 1024 + ch0), x1 = *(const f32x4*)(p.in[23] + l * 1024 + ch0 + 4);
          cb[0] = x0[0]; cb[1] = x0[1]; cb[2] = x0[2]; cb[3] = x0[3]; cb[4] = x1[0]; cb[5] = x1[1]; cb[6] = x1[2]; cb[7] = x1[3]; }
        u32x4 raw[11];
#pragma unroll
        for (int k = 0; k < 11; ++k) { const int r = r0 - 3 + k; raw[k] = *(const u32x4*)(MX + (r < 64 ? (size_t)r : (size_t)b * TP + r) * LDMX + SXBC + ch0); }
#pragma unroll
        for (int k = 0; k < 3; ++k) unpack8(raw[k], win[k]);
#pragma unroll
        for (int i = 0; i < 8; ++i) { float cur[8], o[8]; unpack8(raw[3 + i], cur);
#pragma unroll
            for (int j = 0; j < 8; ++j) { o[j] = siluf_(cb[j] + cw[0][j] * win[0][j] + cw[1][j] * win[1][j] + cw[2][j] * win[2][j] + cw[3][j] * cur[j]); win[0][j] = win[1][j]; win[1][j] = win[2][j]; win[2][j] = cur[j]; }
            *(u32x4*)(dst + (size_t)i * 1024) = pack8(o); }
    }
}
__device__ __forceinline__ float hgrn_lb(const Params& p, int l, int ch) {
    const float* lb = p.in[28];
    const float v0 = lb[ch], v1 = lb[512 + ch], v2 = lb[1024 + ch], v3 = lb[1536 + ch];
    const float m = fmaxf(fmaxf(v0, v1), fmaxf(v2, v3));
    const float e0 = __expf(v0 - m), e1 = __expf(v1 - m), e2 = __expf(v2 - m), e3 = __expf(v3 - m);
    const float inv = 1.f / (e0 + e1 + e2 + e3);
    float acc = 0.f;
    if (l >= 1) acc += e1; if (l >= 2) acc += e2; if (l >= 3) acc += e3;
    return acc * inv;
}

__device__ __forceinline__ void s5_simple(const Params& p, int l, int unit) {
    const int lane = opaque_tid() & 63; const int b = unit >> 5, g = unit & 31;
    const bf16_t* MX = (const bf16_t*)(p.ws + WS_MX); bf16_t* S5P = (bf16_t*)(p.ws + WS_S5P);
    const int gp = (l * 32 + g) * 64 + lane;
    const float step = expf(p.in[19][l * 32 + g]), lr = p.in[12][gp], li = p.in[13][gp];
    const float mag = expf(lr * step); float sn, cs; sincos_turns(li * step * 0.15915494309f, sn, cs);
    const float ar = mag * cs, ai = mag * sn, inv = 1.f / (lr * lr + li * li);
    const float cor = ((ar - 1.f) * lr + ai * li) * inv, coi = (ai * lr - (ar - 1.f) * li) * inv;
    float bbr[16], bbi[16], cre[16], cim[16];
#pragma unroll
    for (int j = 0; j < 16; ++j) { const float br = p.in[14][(size_t)gp * 16 + j], bi = p.in[15][(size_t)gp * 16 + j]; bbr[j] = cor * br - coi * bi; bbi[j] = cor * bi + coi * br;
        cre[j] = p.in[16][((size_t)(l * 32 + g) * 16 + j) * 64 + lane]; cim[j] = p.in[17][((size_t)(l * 32 + g) * 16 + j) * 64 + lane]; }
    const float dsk = p.in[18][l * 512 + g * 16 + (lane & 15)];
    float xr = 0.f, xi = 0.f;
    for (int r = PADF; r < TP; ++r) {
        const size_t row = (size_t)b * TP + r;
        const float uv = bf2f(MX[row * LDMX + S5U + g * 16 + (lane & 15)]);
        float bur = 0.f, bui = 0.f;
#pragma unroll
        for (int j = 0; j < 16; ++j) { const float uj = __shfl(uv, j); bur += bbr[j] * uj; bui += bbi[j] * uj; }
        const float nxr = ar * xr - ai * xi + bur, nxi = ar * xi + ai * xr + bui; xr = nxr; xi = nxi;
        float yv = 0.f;
#pragma unroll
        for (int j = 0; j < 16; ++j) { const float s = wave_sum(xr * cre[j] - xi * cim[j]); yv = (lane == j) ? s : yv; }
        if (lane < 16) { const float y = yv + dsk * uv; S5P[row * 512 + g * 16 + lane] = (bf16_t)f2bf(geluf_(y)); }
    }
}
__device__ __forceinline__ void ret_simple(const Params& p, int l, int unit) {
    const int lane = opaque_tid() & 63; const int b = unit >> 3, hd = (unit >> 1) & 3, eh = unit & 1;
    const bf16_t* MX = (const bf16_t*)(p.ws + WS_MX); bf16_t* BR = (bf16_t*)(p.ws + WS_BR);
    const float gamma = 1.f - exp2f(-5.f - (float)hd);
    const int i = lane & 31; const float invf_t = exp2f(-(float)i * (13.287712379549449f / 32.f)) * 0.15915494309f;
    float h[64];
#pragma unroll
    for (int d = 0; d < 64; ++d) h[d] = 0.f;
    for (int r = PADF; r < TP; ++r) {
        const size_t row = (size_t)b * TP + r; const bf16_t* mx = MX + row * LDMX;
        float sn, cs; sincos_turns((float)(r - PADF) * invf_t, sn, cs);
        const float q1 = bf2f(mx[RQ + hd * 64 + i]), q2 = bf2f(mx[RQ + hd * 64 + 32 + i]), k1 = bf2f(mx[RK + hd * 64 + i]), k2 = bf2f(mx[RK + hd * 64 + 32 + i]);
        const float qr = lane < 32 ? q1 * cs - q2 * sn : q1 * sn + q2 * cs;
        const float kr = (lane < 32 ? k1 * cs - k2 * sn : k1 * sn + k2 * cs) * 0.125f;
        const float v = bf2f(mx[RV + hd * 128 + eh * 64 + lane]);
        float y = 0.f;
#pragma unroll
        for (int d = 0; d < 64; ++d) { const float kd = __shfl(kr, d), qd = __shfl(qr, d); h[d] = gamma * h[d] + kd * v; y += h[d] * qd; }
        BR[row * LDBR + hd * 128 + eh * 64 + lane] = (bf16_t)f2bf(y);
    }
}
__device__ __forceinline__ void ssd_simple(const Params& p, int l, int unit, LAS unsigned char* lds) {
    const int tid = opaque_tid(), lane = tid & 63, w = tid >> 6; const int b = unit >> 3, hd = unit & 7, g = hd >> 2;
    const bf16_t* MX = (const bf16_t*)(p.ws + WS_MX); bf16_t* BR = (bf16_t*)(p.ws + WS_BR); const bf16_t* DT = (const bf16_t*)(p.ws + WS_DT);
    LAS float* xs_s = (LAS float*)lds; LAS float* B_s = xs_s + 64; LAS float* C_s = B_s + 128; LAS float* dt_s = C_s + 128; LAS float* part = dt_s + 64;
    const float a = -expf(p.in[25][l * 8 + hd]), dtb = p.in[24][l * 8 + hd], Dh = p.in[26][l * 8 + hd];
    int ch = 0; float cw[4] = {0.f, 0.f, 0.f, 0.f}, cb = 0.f;
    if (tid < 320) { ch = tid < 64 ? hd * 64 + tid : (tid < 192 ? 512 + g * 128 + (tid - 64) : 768 + g * 128 + (tid - 192));
#pragma unroll
        for (int j = 0; j < 4; ++j) cw[j] = p.in[22][(size_t)(l * 4 + j) * 1024 + ch];
        cb = p.in[23][l * 1024 + ch]; }
    float h[16];
#pragma unroll
    for (int i = 0; i < 16; ++i) h[i] = 0.f;
    for (int r = PADF; r < TP; ++r) {
        const size_t row = (size_t)b * TP + r;
        if (tid < 320) { float o = cb;
#pragma unroll
            for (int j = 0; j < 4; ++j) o += cw[j] * bf2f(MX[(row - 3 + j) * LDMX + SXBC + ch]);
            o = siluf_(o); if (tid < 64) xs_s[tid] = o; else if (tid < 192) B_s[tid - 64] = o; else C_s[tid - 192] = o; }
        if (tid == 320) dt_s[0] = softplusf_(bf2f(DT[row * LDDT + hd]) + dtb);
        __syncthreads();
        const float dt = dt_s[0], da = __expf(dt * a), xv = xs_s[lane] * dt; float pt = 0.f;
#pragma unroll
        for (int i = 0; i < 16; ++i) { h[i] = da * h[i] + B_s[w * 16 + i] * xv; pt += h[i] * C_s[w * 16 + i]; }
        part[w * 64 + lane] = pt;
        __syncthreads();
        if (tid < 64) { float y = 0.f;
#pragma unroll
            for (int k = 0; k < 8; ++k) y += part[k * 64 + tid];
            y += Dh * xs_s[tid]; const float z = bf2f(MX[row * LDMX + SZ + hd * 64 + tid]);
            BR[row * LDBR + 1024 + hd * 64 + tid] = (bf16_t)f2bf(y * siluf_(z)); }
        __syncthreads();
    }
}
__device__ __forceinline__ void hg_simple(const Params& p, int l, int unit, LAS unsigned char* lds) {
    const int tid = opaque_tid(), e = tid & 127, dq = tid >> 7; const int b = unit >> 2, hd = unit & 3;
    const bf16_t* MX = (const bf16_t*)(p.ws + WS_MX); bf16_t* BR = (bf16_t*)(p.ws + WS_BR);
    LAS float* f_s = (LAS float*)lds; LAS float* k_s = f_s + 128; LAS float* q_s = k_s + 128; LAS float* v_s = q_s + 128; LAS float* part = v_s + 128;
    const float lb = hgrn_lb(p, l, hd * 128 + e);
    float h[32];
#pragma unroll
    for (int i = 0; i < 32; ++i) h[i] = 0.f;
    for (int r = PADF; r < TP; ++r) {
        const size_t row = (size_t)b * TP + r; const bf16_t* mx = MX + row * LDMX;
        if (tid < 128) { const float qraw = bf2f(mx[HQ + hd * 128 + tid]), fraw = bf2f(mx[HF + hd * 128 + tid]); const float f = lb + (1.f - lb) * sigmoidf_(fraw);
            f_s[tid] = f; k_s[tid] = 1.f - f; q_s[tid] = siluf_(qraw); }
        else if (tid < 256) v_s[tid - 128] = bf2f(mx[HI + hd * 128 + (tid - 128)]);
        __syncthreads();
        const float v = v_s[e]; float pt = 0.f;
#pragma unroll
        for (int i = 0; i < 32; ++i) { const int d = dq * 32 + i; h[i] = f_s[d] * h[i] + k_s[d] * v; pt += h[i] * q_s[d]; }
        part[dq * 128 + e] = pt;
        __syncthreads();
        if (tid < 128) BR[row * LDBR + 1536 + hd * 128 + tid] = (bf16_t)f2bf(part[tid] + part[128 + tid] + part[256 + tid] + part[384 + tid]);
        __syncthreads();
    }
}


__device__ __forceinline__ bf16x8 ldfrag(const LAS bf16_t* base, int row, int stride, int k) { return *(const LAS bf16x8*)(base + row * stride + k); }
#define MFMA16(a, b, c) __builtin_amdgcn_mfma_f32_16x16x32_bf16(a, b, c, 0, 0, 0)

template <int NT>
__device__ __forceinline__ void meta_tiles(LAS unsigned char* lds, const bf16_t* const (&Ap)[NT], int lda, const bf16_t* const (&Bp)[NT], int ldb, int K, int w, int lane, f32x4 (&out)[NT]) {
    const int r16 = lane & 15, q4 = lane >> 4, ks = K >> 3;
    f32x4 acc[NT][4];
#pragma unroll
    for (int t = 0; t < NT; ++t)
#pragma unroll
        for (int m = 0; m < 4; ++m) acc[t][m] = (f32x4){0.f, 0.f, 0.f, 0.f};
#pragma unroll
    for (int t = 0; t < NT; ++t) {
        const bf16_t* bp = Bp[t] + (size_t)r16 * ldb + w * ks + q4 * 8; const bf16_t* ap = Ap[t] + (size_t)r16 * lda + w * ks + q4 * 8;
#pragma unroll 4
        for (int k0 = 0; k0 < ks; k0 += 32) { const bf16x8 bfr = *(const bf16x8*)(bp + k0);
#pragma unroll
            for (int m = 0; m < 4; ++m) acc[t][m] = MFMA16(bfr, *(const bf16x8*)(ap + (size_t)m * 16 * lda + k0), acc[t][m]); } }
    LAS f32x4* red = (LAS f32x4*)lds;
    __syncthreads();
#pragma unroll
    for (int t = 0; t < NT; ++t)
#pragma unroll
        for (int m = 0; m < 4; ++m) red[((w * NT + t) * 4 + m) * 64 + lane] = acc[t][m];
    __syncthreads();
#pragma unroll
    for (int t = 0; t < NT; ++t) { f32x4 v = (f32x4){0.f, 0.f, 0.f, 0.f};
        if (w < 4) {
#pragma unroll
            for (int ww = 0; ww < 8; ++ww) v = v + red[((ww * NT + t) * 4 + w) * 64 + lane]; }
        out[t] = v; }
}
__device__ __forceinline__ f32x4 meta_tile(LAS unsigned char* lds, const bf16_t* A, int lda, const bf16_t* Bt, int ldb, int K, int brow0, int w, int lane) {
    const bf16_t* const Ap[1] = {A}; const bf16_t* const Bp[1] = {Bt + (size_t)brow0 * ldb}; f32x4 o[1];
    meta_tiles<1>(lds, Ap, lda, Bp, ldb, K, w, lane, o); return o[0];
}

#define META_IDS() const int tid = opaque_tid(), lane = tid & 63, w = __builtin_amdgcn_readfirstlane(tid >> 6), r16 = lane & 15, q4 = lane >> 4; const int row = w * 16 + r16; (void)row; (void)q4
__device__ __forceinline__ void meta_proj(const Params& p, LAS unsigned char* lds) {
    META_IDS();
    const bf16_t* U = (const bf16_t*)(p.ws + WS_U); const bf16_t* W = (const bf16_t*)(p.ws + WS_WIN);
    bf16_t* MX = (bf16_t*)(p.ws + WS_MX); bf16_t* G = (bf16_t*)(p.ws + WS_G); bf16_t* DT = (bf16_t*)(p.ws + WS_DT);
    const int mj0 = gridDim.x == 256 ? (int)blockIdx.x - 192 : (int)blockIdx.x, mjs = gridDim.x == 256 ? 64 : (int)gridDim.x;
    if (mj0 >= 0) for (int jq = mj0; jq < NPROJ / 64; jq += mjs) {
        const bf16_t* const Ap[4] = {U, U, U, U};
        const bf16_t* const Bp[4] = {W + (size_t)(jq * 64) * 1024, W + (size_t)(jq * 64 + 16) * 1024, W + (size_t)(jq * 64 + 32) * 1024, W + (size_t)(jq * 64 + 48) * 1024};
        f32x4 vq[4]; meta_tiles<4>(lds, Ap, 1024, Bp, 1024, 1024, w, lane, vq);
        if (w < 4) {
#pragma unroll
            for (int t = 0; t < 4; ++t) { const f32x4 v = vq[t]; const int col = jq * 64 + t * 16 + q4 * 4;
                if (col >= 5632 && col < 9728) *(unsigned*)((unsigned char*)G + (size_t)row * LDG + (col - 5632)) = gate_q8x4(v[0], v[1], v[2], v[3]);
                else { bf16_t* dst = col < 5632 ? MX + (size_t)row * LDMX + col : DT + (size_t)row * LDDT + (col - 9728);
                    *(u32x2*)dst = (u32x2){pk2(v[0], v[1]), pk2(v[2], v[3])}; } } } }
}
__device__ __forceinline__ void meta_glu(const Params& p, int l, LAS unsigned char* lds) {
    META_IDS();
    const bf16_t* A = (const bf16_t*)(p.ws + WS_S5P); const bf16_t* W = (const bf16_t*)(p.ws + WS_WGLU); bf16_t* BR = (bf16_t*)(p.ws + WS_BR);
    for (int j = blockIdx.x; j < 32; j += gridDim.x) { const int oc0 = j * 16, arow0 = (oc0 >> 7) * 256 + (oc0 & 127);
        const bf16_t* const Ap[2] = {A, A}; const bf16_t* const Bp[2] = {W + (size_t)arow0 * 512, W + (size_t)(arow0 + 128) * 512}; f32x4 vv[2];
        meta_tiles<2>(lds, Ap, 512, Bp, 512, 512, w, lane, vv); const f32x4 va = vv[0], vg = vv[1];
        if (w < 4) { const int oc = oc0 + q4 * 4; const f32x4 ba = *(const f32x4*)(p.in[21] + l * 1024 + oc), bg = *(const f32x4*)(p.in[21] + l * 1024 + 512 + oc);
            f32x4 o;
#pragma unroll
            for (int i = 0; i < 4; ++i) o[i] = (va[i] + ba[i]) * sigmoidf_(vg[i] + bg[i]);
            *(u32x2*)(BR + (size_t)row * LDBR + 512 + oc) = (u32x2){pk2(o[0], o[1]), pk2(o[2], o[3])}; } }
}
__device__ __forceinline__ void meta_merge(const Params& p, LAS unsigned char* lds) {
    META_IDS();
    const bf16_t* BR = (const bf16_t*)(p.ws + WS_BR); const bf16_t* W = (const bf16_t*)(p.ws + WS_WBR); const bf16_t* G = (const bf16_t*)(p.ws + WS_G); bf16_t* O = (bf16_t*)(p.ws + WS_MIXP);
    for (int j = blockIdx.x; j < 64; j += gridDim.x) { f32x4 tot = (f32x4){0.f, 0.f, 0.f, 0.f}; const int col = j * 16 + q4 * 4;
        const bf16_t* const Ap[4] = {BR, BR + 512, BR + 1024, BR + 1536};
        const bf16_t* const Bp[4] = {W + (size_t)(j * 16) * 512, W + ((size_t)1024 + j * 16) * 512, W + ((size_t)2048 + j * 16) * 512, W + ((size_t)3072 + j * 16) * 512};
        f32x4 vz[4]; meta_tiles<4>(lds, Ap, LDBR, Bp, 512, 512, w, lane, vz);
#pragma unroll
        for (int z = 0; z < 4; ++z) { const f32x4 v = vz[z];
            if (w < 4) { const unsigned gw = *(const unsigned*)((const unsigned char*)G + (size_t)row * LDG + z * 1024 + col);
                tot = tot + (f32x4){gate_s(gw, 0), gate_s(gw, 1), gate_s(gw, 2), gate_s(gw, 3)} * (1.f / 256.f) * v; } }
        if (w < 4) *(u32x2*)(O + (size_t)row * 1024 + col) = (u32x2){pk2(tot[0], tot[1]), pk2(tot[2], tot[3])}; }
}
__device__ __forceinline__ void meta_f32(const Params& p, const bf16_t* A, int K, const bf16_t* W, LAS unsigned char* lds) {
    META_IDS();
    bf16_t* D = (bf16_t*)(p.ws + WS_DELTA);
    for (int j = blockIdx.x; j < 64; j += gridDim.x) { const f32x4 v = meta_tile(lds, A, K, W, K, K, j * 16, w, lane);
        if (w < 4) *(u32x2*)(D + (size_t)row * 1024 + j * 16 + q4 * 4) = (u32x2){pk2(v[0], v[1]), pk2(v[2], v[3])}; }
}
__device__ __forceinline__ void meta_up(const Params& p, LAS unsigned char* lds) {
    META_IDS();
    const bf16_t* U = (const bf16_t*)(p.ws + WS_U); const bf16_t* W = (const bf16_t*)(p.ws + WS_WUP); bf16_t* O = (bf16_t*)(p.ws + WS_G);
    for (int j = blockIdx.x; j < 256; j += gridDim.x) { f32x4 v = meta_tile(lds, U, 1024, W, 1024, 1024, j * 16, w, lane);
        if (w < 4) {
#pragma unroll
            for (int i = 0; i < 4; ++i) { const float a = fmaxf(v[i], 0.f); v[i] = a * a; }
            *(u32x2*)(O + (size_t)row * DFF + j * 16 + q4 * 4) = (u32x2){pk2(v[0], v[1]), pk2(v[2], v[3])}; } }
}
constexpr int A_QS = 0, A_KS = 17408, A_QX = 34816, A_KT = 52224, A_VT = 70656, A_PP = 79872, A_ST0 = 89088, A_ST1 = 106496, A_XS = 123904, A_CUM = 133120, A_DEC = 133632, A_TOT = 134144, A_DTA = 136192, A_CUMA = 144640;
static_assert(A_CUMA + 2112 * 4 + 16 <= LDS_BYTES, "lds");

template <int MODE>
__device__ __forceinline__ void attn_unit(const Params& p, int l, int unit, LAS unsigned char* lds) {
    constexpr int DK = MODE == 0 ? 64 : 128, SD = DK + 8, ST = 72, TPW = DK / 32;
    const int tid = opaque_tid(), lane = tid & 63, w = __builtin_amdgcn_readfirstlane(tid >> 6), r16 = lane & 15, q4 = lane >> 4;
    const int b = unit >> 3, hd = MODE == 1 ? (unit & 7) : ((unit >> 1) & 3), half = MODE == 1 ? 0 : (unit & 1), g = hd >> 2;
    const bf16_t* MX = (const bf16_t*)(p.ws + WS_MX); bf16_t* BR = (bf16_t*)(p.ws + WS_BR); const bf16_t* DT = (const bf16_t*)(p.ws + WS_DT); const bf16_t* XBC = (const bf16_t*)(p.ws + WS_XBC);
    LAS bf16_t* QS = (LAS bf16_t*)(lds + A_QS); LAS bf16_t* KS = (LAS bf16_t*)(lds + A_KS); LAS bf16_t* QX = (LAS bf16_t*)(lds + A_QX); LAS bf16_t* KT = (LAS bf16_t*)(lds + A_KT);
    LAS bf16_t* VT = (LAS bf16_t*)(lds + A_VT); LAS bf16_t* PP = (LAS bf16_t*)(lds + A_PP); LAS bf16_t* XS = (LAS bf16_t*)(lds + A_XS);
    LAS float* CUM0 = (LAS float*)(lds + A_CUM); LAS float* DEC = (LAS float*)(lds + A_DEC); LAS float* TOT = (LAS float*)(lds + A_TOT);
    LAS float* DTA = (LAS float*)(lds + A_DTA); LAS float* CUMA = (LAS float*)(lds + A_CUMA);
    float lg = 0.f, Dh = 0.f, lbv = 0.f; float invf_t[4] = {0.f, 0.f, 0.f, 0.f};
    if (MODE == 0) { lg = logf(1.f - exp2f(-5.f - (float)hd));
#pragma unroll
        for (int j = 0; j < 4; ++j) invf_t[j] = exp2f(-(float)((tid & 7) * 4 + j) * (13.287712379549449f / 32.f)) * 0.15915494309f; }
    if (MODE == 2) lbv = hgrn_lb(p, l, hd * 128 + (tid & 127));
    const int VBASE = MODE == 0 ? RV + hd * 128 + half * 64 : HI + hd * 128 + half * 64;
    const int OBASE = MODE == 0 ? hd * 128 + half * 64 : (MODE == 1 ? 1024 + hd * 64 : 1536 + hd * 128 + half * 64);
    __syncthreads();
    if (MODE == 1) {
        Dh = p.in[26][l * 8 + hd];
        const float a_h = -expf(p.in[25][l * 8 + hd]), dtb = p.in[24][l * 8 + hd];
        for (int r = tid; r < TP; r += 512) { const float dt = softplusf_(bf2f(DT[(r < 64 ? (size_t)r : (size_t)b * TP + r) * LDDT + hd]) + dtb); DTA[r] = dt; CUMA[r] = r < PADF ? 0.f : dt * a_h; }
        __syncthreads();
        for (int c = w; c < 33; c += 8) { float cum = CUMA[c * 64 + lane];
#pragma unroll
            for (int o = 1; o < 64; o <<= 1) { const float v = __shfl_up(cum, o); if (lane >= o) cum += v; }
            CUMA[c * 64 + lane] = cum; }
    } else { if (tid < 64) CUM0[tid] = MODE == 0 ? (float)(tid + 1) * lg : 0.f; }
    for (int i = tid; i < 64 * SD / 2; i += 512) ((LAS unsigned*)(lds + A_ST0))[i] = 0u;
    f32x4 st[TPW];
#pragma unroll
    for (int i = 0; i < TPW; ++i) st[i] = (f32x4){0.f, 0.f, 0.f, 0.f};
    u32x2 rq[4]; u32x4 rv; unsigned short hq[16], hf[16]; u32x4 rrow[6];
    auto load_raw = [&](int c) {
        const size_t row0 = c == 0 ? (size_t)0 : (size_t)b * TP + c * 64;
        if (MODE == 0) { const int t = tid >> 3, i0 = (tid & 7) * 4; const bf16_t* mx = MX + (row0 + t) * LDMX;
            rq[0] = *(const u32x2*)(mx + RQ + hd * 64 + i0); rq[1] = *(const u32x2*)(mx + RQ + hd * 64 + 32 + i0); rq[2] = *(const u32x2*)(mx + RK + hd * 64 + i0); rq[3] = *(const u32x2*)(mx + RK + hd * 64 + 32 + i0); }
        if (MODE == 2) { const int d = tid & 127, tq = tid >> 7;
#pragma unroll
            for (int i = 0; i < 16; ++i) { const bf16_t* mx = MX + (row0 + tq * 16 + i) * LDMX; hq[i] = mx[HQ + hd * 128 + d]; hf[i] = mx[HF + hd * 128 + d]; } }
        if (MODE == 0 || MODE == 2) { const int t = tid >> 3, e0 = (tid & 7) * 8; rv = *(const u32x4*)(MX + (row0 + t) * LDMX + VBASE + e0); }
        if (MODE == 1) {
#pragma unroll
            for (int k = 0; k < 3; ++k) { const int pt = tid + 512 * k; if (pt < 1280) { const int cgq = pt >> 5, u = pt & 31;
                const int chq = cgq < 8 ? hd * 64 + cgq * 8 : (cgq < 24 ? 512 + g * 128 + (cgq - 8) * 8 : 768 + g * 128 + (cgq - 24) * 8);
                rrow[2 * k] = *(const u32x4*)(XBC + (row0 + 2 * u) * 1024 + chq); rrow[2 * k + 1] = *(const u32x4*)(XBC + (row0 + 2 * u + 1) * 1024 + chq); } } }
    };
    __syncthreads();
    load_raw(0);
    for (int c = 0; c < 33; ++c) {
        const size_t row0 = (size_t)b * TP + c * 64;
        const LAS bf16_t* STc = (const LAS bf16_t*)(lds + ((c & 1) ? A_ST1 : A_ST0)); LAS bf16_t* STn = (LAS bf16_t*)(lds + ((c & 1) ? A_ST0 : A_ST1));
        const LAS float* CUM = MODE == 1 ? (const LAS float*)(CUMA + c * 64) : (const LAS float*)CUM0;
        u32x2 zw[2];
        if (MODE == 1) {
#pragma unroll
            for (int i = 0; i < 2; ++i) { const int ti = w * 2 + i, mt = ti >> 2, nt = ti & 3; zw[i] = *(const u32x2*)(MX + ((c == 0 ? (size_t)0 : row0) + mt * 16 + r16) * LDMX + SZ + hd * 64 + nt * 16 + q4 * 4); } }
        if (MODE == 0) {
            const int t = tid >> 3, i0 = (tid & 7) * 4;
            const float q1[4] = {bflo(rq[0].x), bfhi(rq[0].x), bflo(rq[0].y), bfhi(rq[0].y)}, q2[4] = {bflo(rq[1].x), bfhi(rq[1].x), bflo(rq[1].y), bfhi(rq[1].y)};
            const float k1[4] = {bflo(rq[2].x), bfhi(rq[2].x), bflo(rq[2].y), bfhi(rq[2].y)}, k2[4] = {bflo(rq[3].x), bfhi(rq[3].x), bflo(rq[3].y), bfhi(rq[3].y)};
            const float pos = (float)(c * 64 + t - PADF), eq = __expf((float)(t + 1) * lg), ek = __expf((float)(63 - t) * lg);
            float a1[4], a2[4], b1[4], b2[4];
#pragma unroll
            for (int j = 0; j < 4; ++j) { float sn, cs; sincos_turns(pos * invf_t[j], sn, cs);
                a1[j] = q1[j] * cs - q2[j] * sn; a2[j] = q1[j] * sn + q2[j] * cs; b1[j] = (k1[j] * cs - k2[j] * sn) * 0.125f; b2[j] = (k1[j] * sn + k2[j] * cs) * 0.125f; }
            *(LAS u32x2*)(QS + t * SD + i0) = (u32x2){pk2(a1[0], a1[1]), pk2(a1[2], a1[3])}; *(LAS u32x2*)(QS + t * SD + 32 + i0) = (u32x2){pk2(a2[0], a2[1]), pk2(a2[2], a2[3])};
            *(LAS u32x2*)(QX + t * SD + i0) = (u32x2){pk2(a1[0] * eq, a1[1] * eq), pk2(a1[2] * eq, a1[3] * eq)}; *(LAS u32x2*)(QX + t * SD + 32 + i0) = (u32x2){pk2(a2[0] * eq, a2[1] * eq), pk2(a2[2] * eq, a2[3] * eq)};
            *(LAS u32x2*)(KS + t * SD + i0) = (u32x2){pk2(b1[0], b1[1]), pk2(b1[2], b1[3])}; *(LAS u32x2*)(KS + t * SD + 32 + i0) = (u32x2){pk2(b2[0], b2[1]), pk2(b2[2], b2[3])};
#pragma unroll
            for (int j = 0; j < 4; ++j) { KT[(i0 + j) * ST + t] = (bf16_t)f2bf(b1[j] * ek); KT[(32 + i0 + j) * ST + t] = (bf16_t)f2bf(b2[j] * ek); }
        }
        if (MODE == 0 || MODE == 2) {
            const int t = tid >> 3, e0 = (tid & 7) * 8; const u32x4 vw = rv;
            VT[(e0 + 0) * ST + t] = (bf16_t)(vw.x & 0xffffu); VT[(e0 + 1) * ST + t] = (bf16_t)(vw.x >> 16); VT[(e0 + 2) * ST + t] = (bf16_t)(vw.y & 0xffffu); VT[(e0 + 3) * ST + t] = (bf16_t)(vw.y >> 16);
            VT[(e0 + 4) * ST + t] = (bf16_t)(vw.z & 0xffffu); VT[(e0 + 5) * ST + t] = (bf16_t)(vw.z >> 16); VT[(e0 + 6) * ST + t] = (bf16_t)(vw.w & 0xffffu); VT[(e0 + 7) * ST + t] = (bf16_t)(vw.w >> 16);
        }
        if (MODE == 2) {
            const int d = tid & 127, tq = tid >> 7;
            float lp[16], kv[16], qv[16]; float run = 1.f; const float oml = 1.f - lbv; const bool padchunk = c == 0;
#pragma unroll
            for (int i = 0; i < 16; ++i) { const int t = tq * 16 + i;
                const float qraw = bf2f(hq[i]), fraw = bf2f(hf[i]);
                const float e = __expf(-fraw), r = __builtin_amdgcn_rcpf(1.f + e);
                float f = (1.f + lbv * e) * r, kk = oml * e * r;
                if (padchunk && t < PADF) { f = 1.f; kk = 0.f; }
                run *= f; lp[i] = run; kv[i] = kk; qv[i] = siluf_(qraw); }
            TOT[tq * 128 + d] = run;
            if (c + 1 < 33) load_raw(c + 1);
            LBAR();
            const float t0 = TOT[d], t1 = TOT[128 + d], t2 = TOT[256 + d], t3 = TOT[384 + d];
            const float pre = (tq > 0 ? t0 : 1.f) * (tq > 1 ? t1 : 1.f) * (tq > 2 ? t2 : 1.f);
            const float cE = tq == 0 ? __builtin_amdgcn_rcpf(t0) * __builtin_amdgcn_rcpf(t1) : (tq == 1 ? __builtin_amdgcn_rcpf(t1) : (tq == 2 ? 1.f : t2));
            const float e63r = t2 * t3;
#pragma unroll
            for (int i4 = 0; i4 < 16; i4 += 4) { float kw[4];
#pragma unroll
                for (int ii = 0; ii < 4; ++ii) { const int i = i4 + ii, t = tq * 16 + i; const float E1 = lp[i] * cE, inv = __builtin_amdgcn_rcpf(E1);
                    const unsigned qq = pk2(qv[i] * E1, qv[i] * (pre * lp[i]));
                    QS[t * SD + d] = (bf16_t)(qq & 0xffffu); QX[t * SD + d] = (bf16_t)(qq >> 16); KS[t * SD + d] = (bf16_t)f2bf(kv[i] * inv); kw[ii] = kv[i] * inv * e63r; }
                *(LAS u32x2*)(KT + d * ST + tq * 16 + i4) = (u32x2){pk2(kw[0], kw[1]), pk2(kw[2], kw[3])}; }
            if (tq == 0) DEC[d] = (t0 * t1) * (t2 * t3);
        }
        if (MODE == 1) {
            const float c63 = CUM[63];
            const int ta_ = 2 * (tid & 31);
            const float cum0 = CUM[ta_], cum1 = CUM[ta_ + 1], dt0 = DTA[c * 64 + ta_], dt1 = DTA[c * 64 + ta_ + 1];
#pragma unroll
            for (int k = 0; k < 3; ++k) { const int pt = tid + 512 * k; if (pt < 1280) { const int cgq = pt >> 5, u = pt & 31, ta = 2 * u;
                float o[2][8]; unpack8(rrow[2 * k], o[0]); unpack8(rrow[2 * k + 1], o[1]);
                if (cgq < 8) { const int e0 = cgq * 8;
                    *(LAS u32x4*)(XS + ta * ST + e0) = rrow[2 * k]; *(LAS u32x4*)(XS + (ta + 1) * ST + e0) = rrow[2 * k + 1];
#pragma unroll
                    for (int j = 0; j < 8; ++j) *(LAS unsigned*)(VT + (e0 + j) * ST + ta) = pk2(o[0][j] * dt0, o[1][j] * dt1); }
                else if (cgq < 24) { const int n0 = (cgq - 8) * 8; const float wk0 = __expf(c63 - cum0), wk1 = __expf(c63 - cum1);
                    *(LAS u32x4*)(KS + ta * SD + n0) = rrow[2 * k]; *(LAS u32x4*)(KS + (ta + 1) * SD + n0) = rrow[2 * k + 1];
#pragma unroll
                    for (int j = 0; j < 8; ++j) *(LAS unsigned*)(KT + (n0 + j) * ST + ta) = pk2(o[0][j] * wk0, o[1][j] * wk1); }
                else { const int n0 = (cgq - 24) * 8; const float eq0 = __expf(cum0), eq1 = __expf(cum1);
                    *(LAS u32x4*)(QS + ta * SD + n0) = rrow[2 * k]; *(LAS u32x4*)(QS + (ta + 1) * SD + n0) = rrow[2 * k + 1];
#pragma unroll
                    for (int j = 0; j < 8; ++j) { o[0][j] *= eq0; o[1][j] *= eq1; }
                    *(LAS u32x4*)(QX + ta * SD + n0) = pack8(o[0]); *(LAS u32x4*)(QX + (ta + 1) * SD + n0) = pack8(o[1]); }
            } }
        }
        if (MODE != 2) { if (c + 1 < 33) load_raw(c + 1); }
        LBAR();
        {   const int mtS = w >> 1;
            f32x4 accS[2] = {(f32x4){0.f, 0.f, 0.f, 0.f}, (f32x4){0.f, 0.f, 0.f, 0.f}};
#pragma unroll
            for (int k0 = 0; k0 < DK; k0 += 32) { const bf16x8 qa = ldfrag(QS, mtS * 16 + r16, SD, k0 + q4 * 8);
#pragma unroll
                for (int i = 0; i < 2; ++i) accS[i] = MFMA16(qa, ldfrag(KS, ((w * 2 + i) & 3) * 16 + r16, SD, k0 + q4 * 8), accS[i]); }
            const f32x4 ct = *(const LAS f32x4*)(CUM + mtS * 16 + q4 * 4);
            float csv[2];
#pragma unroll
            for (int i = 0; i < 2; ++i) csv[i] = CUM[((w * 2 + i) & 3) * 16 + r16];
#pragma unroll
            for (int i = 0; i < 2; ++i) { const int s = ((w * 2 + i) & 3) * 16 + r16;
#pragma unroll
                for (int j = 0; j < 4; ++j) { const int t = mtS * 16 + q4 * 4 + j; const float v = (s <= t) ? accS[i][j] * __expf(ct[j] - csv[i]) : 0.f; PP[t * ST + s] = (bf16_t)f2bf(v); } }
        }
        LBAR();
        {   const int mtY = w >> 1;
            f32x4 accY[2] = {(f32x4){0.f, 0.f, 0.f, 0.f}, (f32x4){0.f, 0.f, 0.f, 0.f}};
#pragma unroll
            for (int k0 = 0; k0 < 64; k0 += 32) { const bf16x8 pa = ldfrag(PP, mtY * 16 + r16, ST, k0 + q4 * 8);
#pragma unroll
                for (int i = 0; i < 2; ++i) accY[i] = MFMA16(ldfrag(VT, ((w * 2 + i) & 3) * 16 + r16, ST, k0 + q4 * 8), pa, accY[i]); }
#pragma unroll
            for (int k0 = 0; k0 < DK; k0 += 32) { const bf16x8 qa = ldfrag(QX, mtY * 16 + r16, SD, k0 + q4 * 8);
#pragma unroll
                for (int i = 0; i < 2; ++i) accY[i] = MFMA16(ldfrag(STc, ((w * 2 + i) & 3) * 16 + r16, SD, k0 + q4 * 8), qa, accY[i]); }
            u32x2 xw[2];
            if (MODE == 1) {
#pragma unroll
                for (int i = 0; i < 2; ++i) xw[i] = *(const LAS u32x2*)(XS + (mtY * 16 + r16) * ST + ((w * 2 + i) & 3) * 16 + q4 * 4); }
            const float decs = MODE == 0 ? __expf(64.f * lg) : (MODE == 1 ? __expf(CUM[63]) : 1.f);
            f32x4 accT[TPW];
#pragma unroll
            for (int i = 0; i < TPW; ++i) { const int ti = w * TPW + i, mt = ti >> 2;
                if (MODE == 2) { const f32x4 dv = *(const LAS f32x4*)(DEC + mt * 16 + q4 * 4); accT[i] = st[i] * dv; } else accT[i] = st[i] * decs; }
#pragma unroll
            for (int k0 = 0; k0 < 64; k0 += 32)
#pragma unroll
                for (int i = 0; i < TPW; ++i) { const int ti = w * TPW + i, mt = ti >> 2, nt = ti & 3;
                    accT[i] = MFMA16(ldfrag(KT, mt * 16 + r16, ST, k0 + q4 * 8), ldfrag(VT, nt * 16 + r16, ST, k0 + q4 * 8), accT[i]); }
#pragma unroll
            for (int i = 0; i < 2; ++i) { const int nt = (w * 2 + i) & 3; f32x4 acc = accY[i];
                const int t = mtY * 16 + r16, e0 = nt * 16 + q4 * 4; const size_t row = row0 + t;
                if (MODE == 1) {
                    acc[0] = (acc[0] + Dh * bflo(xw[i].x)) * siluf_(bflo(zw[i].x)); acc[1] = (acc[1] + Dh * bfhi(xw[i].x)) * siluf_(bfhi(zw[i].x));
                    acc[2] = (acc[2] + Dh * bflo(xw[i].y)) * siluf_(bflo(zw[i].y)); acc[3] = (acc[3] + Dh * bfhi(xw[i].y)) * siluf_(bfhi(zw[i].y)); }
                *(u32x2*)(BR + row * LDBR + OBASE + e0) = (u32x2){pk2(acc[0], acc[1]), pk2(acc[2], acc[3])}; }
#pragma unroll
            for (int i = 0; i < TPW; ++i) { const int ti = w * TPW + i, mt = ti >> 2, nt = ti & 3; st[i] = accT[i];
                *(LAS u32x2*)(STn + (nt * 16 + r16) * SD + mt * 16 + q4 * 4) = (u32x2){pk2(accT[i][0], accT[i][1]), pk2(accT[i][2], accT[i][3])}; }
        }
        LBAR();
    }
}

constexpr int S_US = 0, S_BBT = 4608, S_CC = 20992, S_BU = 38400, S_X = 103936;
static_assert(S_X + 4 * 32 * 136 * 2 <= LDS_BYTES, "lds");
__device__ __forceinline__ void s5_unit(const Params& p, int l, int unit, LAS unsigned char* lds) {
    const int tid = opaque_tid(), lane = tid & 63, w = __builtin_amdgcn_readfirstlane(tid >> 6), r16 = lane & 15, q4 = lane >> 4;
    const int b = unit >> 3, gb = unit & 7;
    const bf16_t* MX = (const bf16_t*)(p.ws + WS_MX); bf16_t* S5P = (bf16_t*)(p.ws + WS_S5P);
    LAS bf16_t* US = (LAS bf16_t*)(lds + S_US); LAS bf16_t* BBT = (LAS bf16_t*)(lds + S_BBT); LAS bf16_t* CC = (LAS bf16_t*)(lds + S_CC); LAS float* BU = (LAS float*)(lds + S_BU); LAS bf16_t* X = (LAS bf16_t*)(lds + S_X);
    __syncthreads();
    float ar = 0.f, ai = 0.f, xr = 0.f, xi = 0.f;
    const int gi_s = tid >> 6, pp = tid & 63;
    if (tid < 256) {
        const int g = gb * 4 + gi_s, gp = (l * 32 + g) * 64 + pp;
        const float step = expf(p.in[19][l * 32 + g]), lr = p.in[12][gp], li = p.in[13][gp];
        const float mag = expf(lr * step); float sn, cs; sincos_turns(li * step * 0.15915494309f, sn, cs);
        ar = mag * cs; ai = mag * sn; const float inv = 1.f / (lr * lr + li * li);
        const float cor = ((ar - 1.f) * lr + ai * li) * inv, coi = (ai * lr - (ar - 1.f) * li) * inv;
#pragma unroll
        for (int j = 0; j < 16; ++j) { const float br = p.in[14][(size_t)gp * 16 + j], bi = p.in[15][(size_t)gp * 16 + j];
            BBT[(gi_s * 128 + pp) * 16 + j] = (bf16_t)f2bf(cor * br - coi * bi); BBT[(gi_s * 128 + 64 + pp) * 16 + j] = (bf16_t)f2bf(cor * bi + coi * br);
            CC[(gi_s * 16 + j) * 136 + pp] = (bf16_t)f2bf(p.in[16][((size_t)(l * 32 + g) * 16 + j) * 64 + pp]); CC[(gi_s * 16 + j) * 136 + 64 + pp] = (bf16_t)f2bf(-p.in[17][((size_t)(l * 32 + g) * 16 + j) * 64 + pp]); }
    }
    __syncthreads();
    const int gi_w = w >> 1, mt_w = w & 1;
    const float* dskp = p.in[18] + l * 512 + gb * 64 + gi_w * 16 + q4 * 4;
    auto urow = [&](int s) -> size_t { return (s < 2 ? (size_t)(s * 32) : (size_t)b * TP + s * 32) + mt_w * 16 + r16; };
    bf16x8 bbf[8], ccf[4];
#pragma unroll
    for (int nt = 0; nt < 8; ++nt) { bbf[nt] = (bf16x8){0, 0, 0, 0, 0, 0, 0, 0}; if (q4 < 2) bbf[nt] = ldfrag(BBT, gi_w * 128 + nt * 16 + r16, 16, q4 * 8); }
#pragma unroll
    for (int k = 0; k < 4; ++k) ccf[k] = ldfrag(CC, gi_w * 16 + r16, 136, k * 32 + q4 * 8);
    bf16x8 afr = (bf16x8){0, 0, 0, 0, 0, 0, 0, 0}; u32x2 uw;
    if (q4 < 2) afr = *(const bf16x8*)(MX + urow(0) * LDMX + S5U + gb * 64 + gi_w * 16 + q4 * 8);
    uw = *(const u32x2*)(MX + urow(0) * LDMX + S5U + gb * 64 + gi_w * 16 + q4 * 4);
    for (int s = 0; s < 66; ++s) {
        const size_t row0 = (size_t)b * TP + s * 32;
#pragma unroll
        for (int nt = 0; nt < 8; ++nt) {
            const f32x4 acc = MFMA16(afr, bbf[nt], ((f32x4){0.f, 0.f, 0.f, 0.f}));
#pragma unroll
            for (int j = 0; j < 4; ++j) BU[(gi_w * 32 + mt_w * 16 + q4 * 4 + j) * 128 + nt * 16 + r16] = acc[j]; }
        const u32x2 uwc = uw;
        if (s + 1 < 66) { if (q4 < 2) afr = *(const bf16x8*)(MX + urow(s + 1) * LDMX + S5U + gb * 64 + gi_w * 16 + q4 * 8);
            uw = *(const u32x2*)(MX + urow(s + 1) * LDMX + S5U + gb * 64 + gi_w * 16 + q4 * 4); }
        LBAR();
        if (tid < 256) {
            float bur_[32], bui_[32];
#pragma unroll
            for (int t = 0; t < 32; ++t) { bur_[t] = BU[(gi_s * 32 + t) * 128 + pp]; bui_[t] = BU[(gi_s * 32 + t) * 128 + 64 + pp]; }
#pragma unroll
            for (int t = 0; t < 32; ++t) { const float bur = bur_[t], bui = bui_[t];
                const float nxr = ar * xr - ai * xi + bur, nxi = ar * xi + ai * xr + bui; xr = nxr; xi = nxi;
                const unsigned pk = pk2(xr, xi); X[(gi_s * 32 + t) * 136 + pp] = (bf16_t)(pk & 0xffffu); X[(gi_s * 32 + t) * 136 + 64 + pp] = (bf16_t)(pk >> 16); } }
        LBAR();
        { f32x4 acc = (f32x4){0.f, 0.f, 0.f, 0.f};
#pragma unroll
            for (int k0 = 0; k0 < 128; k0 += 32) acc = MFMA16(ccf[k0 >> 5], ldfrag(X, gi_w * 32 + mt_w * 16 + r16, 136, k0 + q4 * 8), acc);
            const int t = mt_w * 16 + r16, ch = gi_w * 16 + q4 * 4;
            const f32x4 dsk = *(const f32x4*)dskp;
            const float y0 = geluf_(acc[0] + dsk[0] * bflo(uwc.x)), y1 = geluf_(acc[1] + dsk[1] * bfhi(uwc.x)), y2 = geluf_(acc[2] + dsk[2] * bflo(uwc.y)), y3 = geluf_(acc[3] + dsk[3] * bfhi(uwc.y));
            *(u32x2*)(S5P + (row0 + t) * 512 + gb * 64 + ch) = (u32x2){pk2(y0, y1), pk2(y2, y3)}; }
    }
    __syncthreads();
}

__device__ __forceinline__ void mixer_phase(const Params& p, int l, LAS unsigned char* lds) {
    const int G = gridDim.x, bx = blockIdx.x, wave = opaque_tid() >> 6;
    constexpr int N_SSD = 64, N_HG = FAST_HG ? 64 : 32, N_RET = FAST_RET ? 64 : 0, N_S5 = FAST_S5 ? 64 : 0, NW = N_SSD + N_HG + N_RET + N_S5;
    for (int u0 = bx; u0 < NW; u0 += G) { int u = u0;
        if (u < N_SSD) {
#if FAST_SSD
            attn_unit<1>(p, l, u, lds); if (MIXREP & 1) attn_unit<1>(p, l, u, lds);
#else
            ssd_simple(p, l, u, lds);
#endif
            continue; } u -= N_SSD;
        if (u < N_HG) {
#if FAST_HG
            attn_unit<2>(p, l, u, lds); if (MIXREP & 2) attn_unit<2>(p, l, u, lds);
#else
            hg_simple(p, l, u, lds);
#endif
            continue; } u -= N_HG;
#if FAST_RET
        if (u < N_RET) { attn_unit<0>(p, l, u, lds); if (MIXREP & 4) attn_unit<0>(p, l, u, lds); continue; } u -= N_RET;
#endif
#if FAST_S5
        s5_unit(p, l, u, lds); if (MIXREP & 8) s5_unit(p, l, u, lds);
#endif
    }
    constexpr int NV_S5 = FAST_S5 ? 0 : 256, NV_RET = FAST_RET ? 0 : 64, NV = NV_S5 + NV_RET;
    if (NV > 0) {
        const int nfree = G > NW ? G - NW : G, fb = G > NW ? bx - NW : bx;
        if (fb >= 0) for (int u = wave * nfree + fb; u < NV; u += 8 * nfree) {
#if !FAST_S5
            if (u < NV_S5) { s5_simple(p, l, u); continue; }
#endif
#if !FAST_RET
            ret_simple(p, l, u - NV_S5);
#endif
        }
    }
}

__global__ void __launch_bounds__(512, 2) fwd_megakernel(Params p_arg) {
    extern __shared__ __attribute__((aligned(16))) unsigned char smem[];
    LAS unsigned char* lds = (LAS unsigned char*)smem;
    cg::grid_group grid = cg::this_grid();
    const int G = gridDim.x, bx = blockIdx.x;
    volatile LAS unsigned* xst = (volatile LAS unsigned*)(lds + LDS_BYTES - 16);
    if (threadIdx.x == 0) { xst[0] = 0u; xst[1] = 0u; }
    __syncthreads();
    const XcdBarrier xb = xcd_barrier_post((unsigned*)(fetch_params().ws + WS_BAR), xst);
    if (PHMASK & 1) { const Params p = fetch_params(); norm_phase<0, false>(p, nullptr, p.in[5]);
    convert_layer(p, 0, lds); }
    if (fetch_params().out == nullptr) grid.sync();
    GSYNC();
    for (int l_ = 0; l_ < NLAYERS_RUN; ++l_) {
        int l = l_; asm volatile("" : "+s"(l));
        if (PHMASK & 2) {
            const Params p = fetch_params(); const char* ws = (const char*)p.ws;
            pg8::PlainOrder S{ws + WS_U, ws + WS_WIN, 1024, 1024, 64, NPROJ / 256, G, bx};
            pg8::EpiProj E{p.ws};
            for (int rp = 0; rp < ((REPMASK & 2) ? 2 : 1); ++rp) { if (rp) GSYNC(); pg8::gemm_phase(lds, 1024, 1024, 1024, S, E); }
            meta_proj(p, lds);
        }
        GSYNC();
        { const Params p = fetch_params(); conv_phase(p, l); }
        GSYNC();
        if (PHMASK & 4) { const Params p = fetch_params(); mixer_phase(p, l, lds); }
        if (REPMASK & 4) { GSYNC(); const Params p = fetch_params(); mixer_phase(p, l, lds); }
        GSYNC();
        if (PHMASK & 8) {
            const Params p = fetch_params(); const char* ws = (const char*)p.ws;
            post_phase(p, l);
            pg8::PlainOrder S{ws + WS_S5P, ws + WS_WGLU, 512, 512, 64, 4, G, bx};
            pg8::EpiGlu E{(bf16_t*)(p.ws + WS_BR), p.in[21] + l * 1024};
            for (int rp = 0; rp < ((REPMASK & 8) ? 2 : 1); ++rp) { if (rp) GSYNC(); pg8::gemm_phase(lds, 512, 512, 512, S, E); }
            meta_glu(p, l, lds);
        }
        GSYNC();
        if (PHMASK & 16) {
            const Params p = fetch_params(); const char* ws = (const char*)p.ws;
            pg8::MergeOrder S{ws + WS_BR, ws + WS_WBR, 64, 4, G, bx};
            pg8::EpiMerge E{(bf16_t*)(p.ws + WS_MIXP), (const bf16_t*)(p.ws + WS_G)};
            for (int rp = 0; rp < ((REPMASK & 16) ? 2 : 1); ++rp) { if (rp) GSYNC(); pg8::gemm_phase(lds, LDBR, 512, 512, S, E); }
            meta_merge(p, lds);
        }
        GSYNC();
        if (PHMASK & 32) {
            const Params p = fetch_params(); const char* ws = (const char*)p.ws;
            pg8::PlainOrder S{ws + WS_MIXP, ws + WS_WOUT, 1024, 1024, 64, 4, G, bx};
            pg8::EpiBf E{(bf16_t*)(p.ws + WS_DELTA), 1024};
            for (int rp = 0; rp < ((REPMASK & 32) ? 2 : 1); ++rp) { if (rp) GSYNC(); pg8::gemm_phase(lds, 1024, 1024, 1024, S, E); }
            meta_f32(p, (const bf16_t*)(p.ws + WS_MIXP), 1024, (const bf16_t*)(p.ws + WS_WOUT), lds);
        }
        GSYNC();
        if (PHMASK & 64) { const Params p = fetch_params(); norm_phase<1, false>(p, p.in[6] + l * 1024, p.in[7] + l * 1024); }
        GSYNC();
        if (PHMASK & 128) {
            const Params p = fetch_params(); const char* ws = (const char*)p.ws;
            pg8::PlainOrder S{ws + WS_U, ws + WS_WUP, 1024, 1024, 64, 16, G, bx};
            pg8::EpiUp E{(bf16_t*)(p.ws + WS_G), DFF};
            for (int rp = 0; rp < ((REPMASK & 128) ? 2 : 1); ++rp) { if (rp) GSYNC(); pg8::gemm_phase(lds, 1024, 1024, 1024, S, E); }
            meta_up(p, lds);
        }
        GSYNC();
        if (PHMASK & 256) {
            const Params p = fetch_params(); const char* ws = (const char*)p.ws;
            pg8::PlainOrder S{ws + WS_G, ws + WS_WDN, DFF, DFF, 64, 4, G, bx};
            pg8::EpiBf E{(bf16_t*)(p.ws + WS_DELTA), 1024};
            for (int rp = 0; rp < ((REPMASK & 256) ? 2 : 1); ++rp) { if (rp) GSYNC(); pg8::gemm_phase(lds, DFF, DFF, DFF, S, E); }
            meta_f32(p, (const bf16_t*)(p.ws + WS_G), DFF, (const bf16_t*)(p.ws + WS_WDN), lds);
        }
        GSYNC();
        for (int sr = 0; sr < SYNCREP; ++sr) GSYNC();
        { const Params p = fetch_params();
        if (l + 1 < DEPTH) { norm_phase<1, false>(p, p.in[8] + l * 1024, p.in[5] + (l + 1) * 1024); convert_layer(p, l + 1, lds); GSYNC(); }
        else norm_phase<1, true>(p, p.in[8] + l * 1024, nullptr); }
    }
}

extern "C" void kernel_launch(void* const* d_in, const int* in_sizes, int n_in, void* d_out, int out_size, void* d_ws, size_t ws_size, hipStream_t stream) {
    static int grid_blocks = 0;
    if (grid_blocks == 0) {
        if (n_in != 30 || ws_size < WS_TOTAL) { fprintf(stderr, "kernel_launch: unexpected inputs (n_in %d, ws %zu, need %zu)\n", n_in, ws_size, (size_t)WS_TOTAL); grid_blocks = -1; return; }
        int dev = 0, cus = 0, per_cu = 0;
        hipGetDevice(&dev);
        hipDeviceGetAttribute(&cus, hipDeviceAttributeMultiprocessorCount, dev);
        if (hipFuncSetAttribute((const void*)fwd_megakernel, hipFuncAttributeMaxDynamicSharedMemorySize, LDS_BYTES) != hipSuccess) fprintf(stderr, "kernel_launch: hipFuncSetAttribute failed\n");
        hipOccupancyMaxActiveBlocksPerMultiprocessor(&per_cu, (const void*)fwd_megakernel, 512, LDS_BYTES);
        if (per_cu < 1) { fprintf(stderr, "kernel_launch: occupancy query says %d\n", per_cu); per_cu = 1; }
        (void)hipGetLastError();
        grid_blocks = cus * per_cu;
    }
    if (grid_blocks < 0) return;
    if (hipMemsetAsync((unsigned char*)d_ws + WS_BAR, 0, XCD_BAR_WORDS * 4, stream) != hipSuccess) { fprintf(stderr, "kernel_launch: memset of the barrier words failed\n"); return; }
    Params p{};
    for (int i = 0; i < 30; ++i) p.in[i] = (const float*)d_in[i];
    p.out = (float*)d_out; p.ws = (unsigned char*)d_ws;
    void* args[] = {&p};
    hipError_t e = hipLaunchCooperativeKernel((const void*)fwd_megakernel, dim3(grid_blocks), dim3(512), args, LDS_BYTES, stream);
    if (e != hipSuccess) fprintf(stderr, "cooperative launch failed: %s (grid %d)\n", hipGetErrorString(e), grid_blocks);
}
```

```cpp
#include <hip/hip_runtime.h>
#include <hip/hip_cooperative_groups.h>
#include <cstdio>
#include <cstdint>
namespace cg = cooperative_groups;

#define LAS __attribute__((address_space(3)))
typedef unsigned short bf16_t;
typedef short bf16x8 __attribute__((ext_vector_type(8)));
typedef float f32x4 __attribute__((ext_vector_type(4)));
typedef unsigned u32x4 __attribute__((ext_vector_type(4)));
typedef unsigned u32x2 __attribute__((ext_vector_type(2)));

#ifdef NOSYNC
#define GSYNC() __syncthreads()
#else
#define GSYNC() xcd_barrier(xb)
#endif
#ifndef NLAYERS_RUN
#define NLAYERS_RUN DEPTH
#endif
#ifndef EPIREP
#define EPIREP 0
#endif
#ifndef SYNCREP
#define SYNCREP 0
#endif
#ifndef MIXREP
#define MIXREP 0
#endif
#ifndef REPMASK
#define REPMASK 0
#endif
#ifndef PHMASK
#define PHMASK 0xFFFF
#endif
#ifndef FAST_RET
#define FAST_RET 1
#endif
#ifndef FAST_SSD
#define FAST_SSD 1
#endif
#ifndef FAST_HG
#define FAST_HG 1
#endif
#ifndef FAST_S5
#define FAST_S5 1
#endif

constexpr int NB = 8, SEQ = 2048, DM = 1024, DEPTH = 4, PADF = 48, TP = 2112  , MROWS = NB * TP  ;
constexpr int NPROJ = 9984, DFF = 4096, LDMX = 5632, LDG = 4096, LDDT = 256, LDBR = 2048;
constexpr float EPS = 1e-6f;
constexpr int RQ = 0, RK = 256, RV = 512, RG = 1024, S5U = 1536, SZ = 2048, SXBC = 2560, HQ = 3584, HF = 4096, HI = 4608, HGT = 5120;
constexpr size_t SZ_WIN = (size_t)NPROJ * 1024 * 2, SZ_WBR = (size_t)4 * 1024 * 512 * 2, SZ_WOUT = (size_t)1024 * 1024 * 2, SZ_WUP = (size_t)4096 * 1024 * 2, SZ_WDN = SZ_WUP, SZ_WGLU = (size_t)1024 * 512 * 2;
constexpr size_t WS_WIN = 0, WS_WBR = WS_WIN + SZ_WIN, WS_WOUT = WS_WBR + SZ_WBR, WS_WUP = WS_WOUT + SZ_WOUT, WS_WDN = WS_WUP + SZ_WUP, WS_WGLU = WS_WDN + SZ_WDN;
constexpr size_t WS_H = WS_WGLU + SZ_WGLU;
constexpr size_t WS_U = WS_H + (size_t)MROWS * 1024 * 4;
constexpr size_t WS_MX = WS_U + (size_t)MROWS * 1024 * 2;
constexpr size_t WS_G = WS_MX + (size_t)MROWS * LDMX * 2;
constexpr size_t WS_DT = WS_G + (size_t)MROWS * LDG * 2;
constexpr size_t WS_BR = WS_DT + (size_t)MROWS * LDDT * 2;
constexpr size_t WS_S5P = WS_BR + (size_t)MROWS * LDBR * 2;
constexpr size_t WS_END = WS_S5P + (size_t)MROWS * 512 * 2;
constexpr size_t WS_BAR = (WS_END + 255) & ~(size_t)255, WS_XBC = WS_BAR + 16384  , WS_TOTAL = WS_XBC + (size_t)MROWS * 1024 * 2;
constexpr size_t WS_MIXP = WS_MX;
constexpr size_t WS_DELTA = WS_MX + ((size_t)64 << 20);
static_assert(WS_DELTA + (size_t)MROWS * 1024 * 4 <= WS_G, "overlay");
constexpr int LDS_BYTES = 163840;

struct Params { const float* in[30]; float* out; unsigned char* ws; };
typedef const unsigned char __attribute__((address_space(4))) kbyte_t;
__device__ __forceinline__ Params fetch_params() {
#if defined(__HIP_DEVICE_COMPILE__)
    kbyte_t* k = (kbyte_t*)__builtin_amdgcn_kernarg_segment_ptr(); asm volatile("" : "+s"(k));
    typedef const unsigned long long __attribute__((address_space(4))) ku64_t;
    Params p;
#pragma unroll
    for (int i = 0; i < 30; ++i) p.in[i] = (const float*)(const float __attribute__((address_space(1)))*)((ku64_t*)k)[i];
    p.out = (float*)(float __attribute__((address_space(1)))*)((ku64_t*)k)[30]; p.ws = (unsigned char*)(unsigned char __attribute__((address_space(1)))*)((ku64_t*)k)[31];
    return p;
#else
    return Params{};
#endif
}

__device__ __forceinline__ int opaque_tid() { int t = threadIdx.x; asm volatile("" : "+v"(t)); return t; }
#define LDS_WAIT() asm volatile("s_waitcnt lgkmcnt(0)" ::: "memory")
#define LBAR() do { asm volatile("s_waitcnt lgkmcnt(0)" ::: "memory"); __builtin_amdgcn_s_barrier(); asm volatile("" ::: "memory"); } while (0)
typedef float f32x2_ __attribute__((ext_vector_type(2)));
typedef __bf16 bf16x2_ __attribute__((ext_vector_type(2)));
__device__ __forceinline__ unsigned pk2(float lo, float hi) { const f32x2_ v = {lo, hi}; return __builtin_bit_cast(unsigned, __builtin_convertvector(v, bf16x2_)); }
__device__ __forceinline__ unsigned f2bf(float f) { return (unsigned)__builtin_bit_cast(unsigned short, (__bf16)f); }
__device__ __forceinline__ float bf2f(unsigned b) { return __builtin_bit_cast(float, (b & 0xffffu) << 16); }
__device__ __forceinline__ float bflo(unsigned w) { return __builtin_bit_cast(float, w << 16); }
__device__ __forceinline__ float bfhi(unsigned w) { return __builtin_bit_cast(float, w & 0xffff0000u); }
__device__ __forceinline__ float wave_sum(float v) {
#pragma unroll
    for (int o = 1; o < 64; o <<= 1) v += __shfl_xor(v, o);
    return v;
}
__device__ __forceinline__ float sigmoidf_(float x) { return __builtin_amdgcn_rcpf(1.0f + __expf(-x)); }
__device__ __forceinline__ float siluf_(float x) { return x * __builtin_amdgcn_rcpf(1.0f + __expf(-x)); }
__device__ __forceinline__ float softplusf_(float x) { return x > 20.f ? x : log1pf(__expf(x)); }
__device__ __forceinline__ float geluf_(float x) { const float z = 0.7978845608f * (x + 0.044715f * x * x * x); const float e = __expf(2.f * z); const float th = 1.f - 2.f * __builtin_amdgcn_rcpf(e + 1.f); return 0.5f * x * (1.f + th); }
__device__ __forceinline__ void sincos_turns(float turns, float& s, float& c) { const float fr = turns - floorf(turns); s = __builtin_amdgcn_sinf(fr); c = __builtin_amdgcn_cosf(fr); }


__device__ __forceinline__ float gate_qf(float g) { return sigmoidf_(g) * 256.f - 0.5f; }
__device__ __forceinline__ unsigned gate_q8x4(float a, float b, float c, float d) {
    unsigned w = __builtin_amdgcn_cvt_pk_u8_f32(gate_qf(a), 0u, 0u); w = __builtin_amdgcn_cvt_pk_u8_f32(gate_qf(b), 1u, w); w = __builtin_amdgcn_cvt_pk_u8_f32(gate_qf(c), 2u, w); return __builtin_amdgcn_cvt_pk_u8_f32(gate_qf(d), 3u, w); }
__device__ __forceinline__ float gate_s(unsigned w, int byte) { return (float)((w >> (8 * byte)) & 255u) + 0.5f; }
#define XB_TMO      128
#define XB_XCNT(j)  (256  + 64 * (j))
#define XB_XSUB(j)  (1280 + 64 * (j))
#define XB_XGEN(j)  (2304 + 64 * (j))
#define XB_TOP      3328
#define XB_TOPGEN   3392
#define XCD_BAR_WORDS 3456
#define XB_SPIN_CAP (1u << 18)

__device__ __forceinline__ unsigned xb_ld(unsigned* p)              { return __hip_atomic_load(p, __ATOMIC_RELAXED, __HIP_MEMORY_SCOPE_AGENT); }
__device__ __forceinline__ unsigned xb_add(unsigned* p, unsigned v) { return __hip_atomic_fetch_add(p, v, __ATOMIC_RELAXED, __HIP_MEMORY_SCOPE_AGENT); }
__device__ __forceinline__ unsigned xb_xcc_id() { return (unsigned)__builtin_amdgcn_s_getreg((3 << 11) | 20) & 0xFu; }
#define XB_SPIN(cond, bar) do { unsigned _sp = 0; while (cond) { __builtin_amdgcn_s_sleep(1); \
    if ((++_sp & 255u) == 0u) { if (xb_ld(&(bar)[XB_TMO])) break; if (_sp > XB_SPIN_CAP) { atomicAdd(&(bar)[XB_TMO], 1u); break; } } } } while (0)

struct XcdBarrier {
    unsigned* bar; unsigned x;
    volatile LAS unsigned* st;
};

__device__ __forceinline__ XcdBarrier xcd_barrier_post(unsigned* bar, volatile LAS unsigned* st) {
    XcdBarrier b; b.bar = bar; b.x = xb_xcc_id(); b.st = st;
    if (threadIdx.x == 0) (void)xb_add(&bar[XB_XCNT(b.x)], 1u);
    return b;
}
__device__ __forceinline__ void xcd_barrier_complete(unsigned* bar, unsigned x, unsigned& nloc, unsigned& nx) {
    const unsigned G = gridDim.x * gridDim.y * gridDim.z;
    unsigned sum, cnt, mine, sp = 0u;
    for (;;) {
        sum = 0u; cnt = 0u; mine = 0u;
#pragma unroll
        for (unsigned j = 0; j < 16; ++j) { const unsigned c = xb_ld(&bar[XB_XCNT(j)]); sum += c; cnt += (c > 0u) ? 1u : 0u; mine = (j == x) ? c : mine; }
        if (sum == G) break;
        __builtin_amdgcn_s_sleep(1);
        if ((++sp & 255u) == 0u) { if (xb_ld(&bar[XB_TMO])) break; if (sp > XB_SPIN_CAP) { atomicAdd(&bar[XB_TMO], 1u); break; } }
    }
    nloc = mine > 0u ? mine : 1u; nx = cnt > 0u ? cnt : 1u;
}

__device__ __forceinline__ void xcd_barrier(const XcdBarrier& b) {
    asm volatile("s_waitcnt vmcnt(0)" ::: "memory");
    __syncthreads();
    if (threadIdx.x == 0) {
        unsigned* bar = b.bar;
        __builtin_amdgcn_s_waitcnt(0);
        unsigned nloc = b.st[0], nx = b.st[1];
        if (nloc == 0u) { xcd_barrier_complete(bar, b.x, nloc, nx); b.st[0] = nloc; b.st[1] = nx; }
        const unsigned old = xb_add(&bar[XB_XSUB(b.x)], 1u);
        const unsigned gen = old / nloc;
        if (old + 1u == (gen + 1u) * nloc) {
            __builtin_amdgcn_fence(__ATOMIC_RELEASE, "agent");
            asm volatile("s_waitcnt vmcnt(0)" ::: "memory");
            const unsigned og = xb_add(&bar[XB_TOP], 1u);
            const unsigned tg = og / nx;
            if (og + 1u == (tg + 1u) * nx) xb_add(&bar[XB_TOPGEN], 1u);
            else XB_SPIN(xb_ld(&bar[XB_TOPGEN]) == tg, bar);
            __builtin_amdgcn_fence(__ATOMIC_ACQUIRE, "agent");
            xb_add(&bar[XB_XGEN(b.x)], 1u);
            asm volatile("s_waitcnt vmcnt(0)" ::: "memory");
        } else {
            XB_SPIN(xb_ld(&bar[XB_XGEN(b.x)]) == gen, bar);
            __builtin_amdgcn_fence(__ATOMIC_ACQUIRE, "agent");
            asm volatile("s_waitcnt vmcnt(0)" ::: "memory");
        }
    }
    __syncthreads();
}


__device__ __forceinline__ void unpack8(const u32x4 w, float (&v)[8]);
namespace pg8 {
constexpr int BM = 256, BK = 64, HALF = 128, HTB = HALF * BK * 2, STAGE_BYTES = 8 * HTB, NXCD = 8, WGM = 8;
__device__ __forceinline__ int lds_byte(int r, int c) { const int st = (r >> 4) * 2 + (c >> 5), rr = r & 15, cc = c & 31, ob = rr * 64 + cc * 2; return st * 1024 + (ob ^ (((ob >> 9) & 1) << 5)); }
__device__ __forceinline__ void stage_rc(int b, int& R, int& C) { const int st = b / 1024, sb = b % 1024, swz = sb ^ (((sb >> 9) & 1) << 5); R = (st >> 1) * 16 + swz / 64; C = (st & 1) * 32 + (swz % 64) / 2; }
__device__ __forceinline__ int perm32(int rho) { const int n = rho >> 4, i = rho & 15; return 8 * (i >> 2) + 4 * n + (i & 3); }
struct Unit { int pm, pn, z, row0; const char* A; const char* B; };
__device__ __forceinline__ int tile_row0(int pm) { return (pm >> 3) * TP + 64 + (pm & 7) * 256; }
__device__ __forceinline__ void tile_of(int wgid, int nM, int nN, int& pm, int& pn) {
    const int nwg = nM * nN; { const int q = nwg / NXCD, r = nwg % NXCD, xcd = wgid % NXCD, off = wgid / NXCD; wgid = (xcd < r ? xcd * (q + 1) : r * (q + 1) + (xcd - r) * q) + off; }
    const int nig = WGM * nN, gid = wgid / nig, fm = gid * WGM, gsz = (nM - fm) < WGM ? (nM - fm) : WGM;
    pm = fm + ((wgid % nig) % gsz); pn = (wgid % nig) / gsz;
}
struct PlainOrder {
    const char* A; const char* B; int lda, ldb, nM, nN, G, c;
    __device__ __forceinline__ bool next(int i, Unit& u) const {
        const long L = (long)i * G + c; if (L >= (long)nM * nN) return false;
        tile_of((int)L, nM, nN, u.pm, u.pn); u.z = 0;
        u.row0 = tile_row0(u.pm); u.A = A + (size_t)u.row0 * lda * 2; u.B = B + (size_t)u.pn * 256 * ldb * 2; return true;
    }
};
struct MergeOrder {
    const char* A; const char* B; int nM, nN, G, c;
    __device__ __forceinline__ bool next(int i, Unit& u) const {
        const long L = (long)(i >> 2) * G + c; if (L >= (long)nM * nN) return false;
        tile_of((int)L, nM, nN, u.pm, u.pn); u.z = i & 3;
        u.row0 = tile_row0(u.pm); u.A = A + ((size_t)u.row0 * LDBR + (size_t)u.z * 512) * 2; u.B = B + ((size_t)u.z * 1024 * 512 + (size_t)u.pn * 256 * 512) * 2; return true;
    }
};
__device__ __forceinline__ unsigned cvt_pk_bf16(float lo, float hi) { return pk2(lo, hi); }

struct EpiF32 {
    static constexpr bool PERM = false, RMW = false, CHAIN = false;
    float* C; int ldc;
    __device__ __forceinline__ void operator()(const f32x4 (&acc)[2][2][4][2], const Unit& u, int wr, int wc, int fr, int fq) const {
        const int row0 = u.row0 + wr * 64 + fr, col0 = u.pn * BM + wc * 32 + 4 * fq;
#pragma unroll
        for (int ai = 0; ai < 2; ++ai)
#pragma unroll
            for (int m = 0; m < 4; ++m) { float* rowp = C + (size_t)(row0 + ai * HALF + m * 16) * ldc + col0;
#pragma unroll
                for (int bj = 0; bj < 2; ++bj)
#pragma unroll
                    for (int n = 0; n < 2; ++n) *(f32x4*)(rowp + bj * HALF + n * 16) = acc[ai][bj][m][n]; }
    }
};
struct EpiProj {
    static constexpr bool PERM = true, RMW = false, CHAIN = false;
    unsigned char* ws;
    __device__ __forceinline__ void operator()(const f32x4 (&acc)[2][2][4][2], const Unit& u, int wr, int wc, int fr, int fq) const {
        bf16_t* const MX = (bf16_t*)(ws + WS_MX); unsigned char* const G = ws + WS_G; bf16_t* const DT = (bf16_t*)(ws + WS_DT);
        bf16_t* base; int ldc, colt;
        const bool isg = u.pn >= 22 && u.pn < 38;
        if (u.pn < 22) { base = MX; ldc = LDMX; colt = u.pn * 256; } else { base = DT; ldc = LDDT; colt = isg ? (u.pn - 22) * 256 : 0; }
        const int row0 = u.row0 + wr * 64 + fr, col0 = colt + wc * 32 + 8 * fq;
        if (isg) {
            unsigned char* G8 = G;
#pragma unroll
            for (int ai = 0; ai < 2; ++ai)
#pragma unroll
                for (int m = 0; m < 4; ++m) { unsigned char* rowp = G8 + (size_t)(row0 + ai * HALF + m * 16) * LDG + col0;
#pragma unroll
                    for (int bj = 0; bj < 2; ++bj) { const f32x4 v0 = acc[ai][bj][m][0], v1 = acc[ai][bj][m][1];
                        *(u32x2*)(rowp + bj * HALF) = (u32x2){gate_q8x4(v0[0], v0[1], v0[2], v0[3]), gate_q8x4(v1[0], v1[1], v1[2], v1[3])}; } }
        } else {
#pragma unroll
        for (int ai = 0; ai < 2; ++ai)
#pragma unroll
            for (int m = 0; m < 4; ++m) { bf16_t* rowp = base + (size_t)(row0 + ai * HALF + m * 16) * ldc + col0;
#pragma unroll
                for (int bj = 0; bj < 2; ++bj) { const f32x4 v0 = acc[ai][bj][m][0], v1 = acc[ai][bj][m][1];
                    u32x4 w; w.x = cvt_pk_bf16(v0[0], v0[1]); w.y = cvt_pk_bf16(v0[2], v0[3]); w.z = cvt_pk_bf16(v1[0], v1[1]); w.w = cvt_pk_bf16(v1[2], v1[3]);
                    *(u32x4*)(rowp + bj * HALF) = w; } }
        }
    }
};
struct EpiBf {
    static constexpr bool PERM = true, RMW = false, CHAIN = false;
    bf16_t* O; int ldc;
    __device__ __forceinline__ void operator()(const f32x4 (&acc)[2][2][4][2], const Unit& u, int wr, int wc, int fr, int fq) const {
        const int row0 = u.row0 + wr * 64 + fr, col0 = u.pn * BM + wc * 32 + 8 * fq;
#pragma unroll
        for (int ai = 0; ai < 2; ++ai)
#pragma unroll
            for (int m = 0; m < 4; ++m) { bf16_t* rowp = O + (size_t)(row0 + ai * HALF + m * 16) * ldc + col0;
#pragma unroll
                for (int bj = 0; bj < 2; ++bj) { const f32x4 v0 = acc[ai][bj][m][0], v1 = acc[ai][bj][m][1];
                    u32x4 w; w.x = cvt_pk_bf16(v0[0], v0[1]); w.y = cvt_pk_bf16(v0[2], v0[3]); w.z = cvt_pk_bf16(v1[0], v1[1]); w.w = cvt_pk_bf16(v1[2], v1[3]);
                    *(u32x4*)(rowp + bj * HALF) = w; } }
    }
};
struct EpiUp {
    static constexpr bool PERM = true, RMW = false, CHAIN = false;
    bf16_t* O; int ldc;
    __device__ __forceinline__ void operator()(const f32x4 (&acc)[2][2][4][2], const Unit& u, int wr, int wc, int fr, int fq) const {
        const int row0 = u.row0 + wr * 64 + fr, col0 = u.pn * BM + wc * 32 + 8 * fq;
#pragma unroll
        for (int ai = 0; ai < 2; ++ai)
#pragma unroll
            for (int m = 0; m < 4; ++m) { bf16_t* rowp = O + (size_t)(row0 + ai * HALF + m * 16) * ldc + col0;
#pragma unroll
                for (int bj = 0; bj < 2; ++bj) { f32x4 v0 = acc[ai][bj][m][0], v1 = acc[ai][bj][m][1];
#pragma unroll
                    for (int j = 0; j < 4; ++j) { const float a = fmaxf(v0[j], 0.f), b = fmaxf(v1[j], 0.f); v0[j] = a * a; v1[j] = b * b; }
                    u32x4 w; w.x = cvt_pk_bf16(v0[0], v0[1]); w.y = cvt_pk_bf16(v0[2], v0[3]); w.z = cvt_pk_bf16(v1[0], v1[1]); w.w = cvt_pk_bf16(v1[2], v1[3]);
                    *(u32x4*)(rowp + bj * HALF) = w; } }
    }
};
struct EpiGlu {
    static constexpr bool PERM = true, RMW = false, CHAIN = false;
    bf16_t* BR; const float* bias;
    __device__ __forceinline__ void operator()(const f32x4 (&acc)[2][2][4][2], const Unit& u, int wr, int wc, int fr, int fq) const {
        const int row0 = u.row0 + wr * 64 + fr, oc = u.pn * 128 + wc * 32 + 8 * fq;
        const f32x4 ba0 = *(const f32x4*)(bias + oc), ba1 = *(const f32x4*)(bias + oc + 4), bg0 = *(const f32x4*)(bias + 512 + oc), bg1 = *(const f32x4*)(bias + 512 + oc + 4);
#pragma unroll
        for (int ai = 0; ai < 2; ++ai)
#pragma unroll
            for (int m = 0; m < 4; ++m) { bf16_t* rowp = BR + (size_t)(row0 + ai * HALF + m * 16) * LDBR + 512 + oc;
                f32x4 a0 = acc[ai][0][m][0] + ba0, a1 = acc[ai][0][m][1] + ba1; const f32x4 g0 = acc[ai][1][m][0] + bg0, g1 = acc[ai][1][m][1] + bg1;
#pragma unroll
                for (int j = 0; j < 4; ++j) { a0[j] = a0[j] * sigmoidf_(g0[j]); a1[j] = a1[j] * sigmoidf_(g1[j]); }
                u32x4 w; w.x = cvt_pk_bf16(a0[0], a0[1]); w.y = cvt_pk_bf16(a0[2], a0[3]); w.z = cvt_pk_bf16(a1[0], a1[1]); w.w = cvt_pk_bf16(a1[2], a1[3]);
                *(u32x4*)rowp = w; }
    }
};
struct EpiMerge {
    static constexpr bool PERM = true, RMW = true, CHAIN = true;
    bf16_t* O; const bf16_t* G;
    __device__ __forceinline__ void operator()(f32x4 (&acc)[2][2][4][2], const Unit& u, int wr, int wc, int fr, int fq) const {
        const int row0 = u.row0 + wr * 64 + fr, col0 = u.pn * BM + wc * 32 + 8 * fq;
        const unsigned char* G8 = (const unsigned char*)G;
        if (u.z < 3) {
#pragma unroll
            for (int ai = 0; ai < 2; ++ai)
#pragma unroll
                for (int m = 0; m < 4; ++m) { const size_t row = (size_t)(row0 + ai * HALF + m * 16);
#pragma unroll
                    for (int bj = 0; bj < 2; ++bj) { const int col = col0 + bj * HALF;
                        const u32x2 ga = *(const u32x2*)(G8 + row * LDG + u.z * 1024 + col), gb = *(const u32x2*)(G8 + row * LDG + (u.z + 1) * 1024 + col);
                        { f32x4 r0, r1;
                          r0[0] = gate_s(ga.x, 0) * __builtin_amdgcn_rcpf(gate_s(gb.x, 0)); r0[1] = gate_s(ga.x, 1) * __builtin_amdgcn_rcpf(gate_s(gb.x, 1)); r0[2] = gate_s(ga.x, 2) * __builtin_amdgcn_rcpf(gate_s(gb.x, 2)); r0[3] = gate_s(ga.x, 3) * __builtin_amdgcn_rcpf(gate_s(gb.x, 3));
                          r1[0] = gate_s(ga.y, 0) * __builtin_amdgcn_rcpf(gate_s(gb.y, 0)); r1[1] = gate_s(ga.y, 1) * __builtin_amdgcn_rcpf(gate_s(gb.y, 1)); r1[2] = gate_s(ga.y, 2) * __builtin_amdgcn_rcpf(gate_s(gb.y, 2)); r1[3] = gate_s(ga.y, 3) * __builtin_amdgcn_rcpf(gate_s(gb.y, 3));
                          acc[ai][bj][m][0] = acc[ai][bj][m][0] * r0; acc[ai][bj][m][1] = acc[ai][bj][m][1] * r1; } } }
        } else {
#pragma unroll
            for (int ai = 0; ai < 2; ++ai)
#pragma unroll
                for (int m = 0; m < 4; ++m) { const size_t row = (size_t)(row0 + ai * HALF + m * 16);
#pragma unroll
                    for (int bj = 0; bj < 2; ++bj) { const int col = col0 + bj * HALF;
                        const u32x2 gw = *(const u32x2*)(G8 + row * LDG + 3 * 1024 + col);
                        f32x4 v0 = acc[ai][bj][m][0], v1 = acc[ai][bj][m][1];
                        v0 = v0 * (f32x4){gate_s(gw.x, 0), gate_s(gw.x, 1), gate_s(gw.x, 2), gate_s(gw.x, 3)} * (1.f / 256.f); v1 = v1 * (f32x4){gate_s(gw.y, 0), gate_s(gw.y, 1), gate_s(gw.y, 2), gate_s(gw.y, 3)} * (1.f / 256.f);
                        u32x4 w; w.x = cvt_pk_bf16(v0[0], v0[1]); w.y = cvt_pk_bf16(v0[2], v0[3]); w.z = cvt_pk_bf16(v1[0], v1[1]); w.w = cvt_pk_bf16(v1[2], v1[3]);
                        *(u32x4*)(O + row * 1024 + col) = w; } }
        }
    }
};

template <class Epi, class Sched>
__device__ __forceinline__ void gemm_phase(LAS unsigned char* lds, const int lda, const int ldb, const int K, const Sched& S, const Epi& E) {
    int tid_ = threadIdx.x; asm volatile("" : "+v"(tid_));
    const int tid = tid_, wid = __builtin_amdgcn_readfirstlane(tid >> 6), lane = tid & 63, wr = wid >> 2, wc = wid & 3, fr = lane & 15, fq = lane >> 4;
    const int nt = K / BK;
    unsigned voffA[2], voffB[2];
#pragma unroll
    for (int i = 0; i < 2; ++i) { int R, C; stage_rc(tid * 16 + i * 8192, R, C); const int Rb = Epi::PERM ? ((R & ~31) + perm32(R & 31)) : R;
        voffA[i] = (unsigned)(R * lda + C) * 2u; voffB[i] = (unsigned)(Rb * ldb + C) * 2u; }
    const size_t kstep = (size_t)(BK * 2);
    const size_t hstepA = (size_t)HALF * lda * 2, hstepB = (size_t)HALF * ldb * 2;
    const unsigned ldsw = (unsigned)wid * 1024u;
    const int aoff = lds_byte(wr * 64 + fr, fq * 8), boff = lds_byte(wc * 32 + fr, fq * 8);
#define PG8_SA(b, h) (((b) * 2 + (h)) * HTB)
#define PG8_SB(b, h) ((4 + (b) * 2 + (h)) * HTB)
#define PG8_STAGE(bufoff, gbase, voff) do { _Pragma("unroll") for (int _i = 0; _i < 2; ++_i) \
        __builtin_amdgcn_global_load_lds((const unsigned*)((const char*)(gbase) + (voff)[_i]), (LAS unsigned*)(lds + (bufoff) + ldsw + _i * 8192), 16, 0, 0); } while (0)
#define PG8_LDA(dst, b, h) do { _Pragma("unroll") for (int m = 0; m < 4; ++m) _Pragma("unroll") for (int k = 0; k < 2; ++k) dst[m][k] = *(const LAS bf16x8*)(lds + PG8_SA(b, h) + aoff + m * 2048 + k * 1024); } while (0)
#define PG8_LDB(dst, b, h) do { _Pragma("unroll") for (int n = 0; n < 2; ++n) _Pragma("unroll") for (int k = 0; k < 2; ++k) dst[n][k] = *(const LAS bf16x8*)(lds + PG8_SB(b, h) + boff + n * 2048 + k * 1024); } while (0)
#define PG8_MMA(ai, bj, At, Bt) do { __builtin_amdgcn_s_setprio(1); _Pragma("unroll") for (int m = 0; m < 4; ++m) _Pragma("unroll") for (int n = 0; n < 2; ++n) _Pragma("unroll") for (int k = 0; k < 2; ++k) \
        acc[ai][bj][m][n] = __builtin_amdgcn_mfma_f32_16x16x32_bf16(Bt[n][k], At[m][k], acc[ai][bj][m][n], 0, 0, 0); __builtin_amdgcn_s_setprio(0); } while (0)
#define PG8_WAIT_V(n) asm volatile("s_waitcnt vmcnt(" #n ")" ::: "memory")
#define PG8_WAIT_L(n) asm volatile("s_waitcnt lgkmcnt(" #n ")" ::: "memory")
#define PG8_BAR __builtin_amdgcn_s_barrier()
#define PG8_SCHED __builtin_amdgcn_sched_barrier(0)
    Unit cur, nxt; int ui = 0;
    if (!S.next(0, cur)) return;
    f32x4 acc[2][2][4][2];
#pragma unroll
    for (int a = 0; a < 2; ++a)
#pragma unroll
        for (int b = 0; b < 2; ++b)
#pragma unroll
            for (int m = 0; m < 4; ++m)
#pragma unroll
                for (int n = 0; n < 2; ++n) acc[a][b][m][n] = (f32x4){0.f, 0.f, 0.f, 0.f};
    bf16x8 At[4][2], B0[2][2], B1[2][2];
    const char* cA = cur.A; const char* cB = cur.B;
    PG8_STAGE(PG8_SB(0, 0), cB, voffB); PG8_STAGE(PG8_SB(0, 1), cB + hstepB, voffB); PG8_STAGE(PG8_SA(0, 0), cA, voffA); PG8_STAGE(PG8_SA(0, 1), cA + hstepA, voffA);
    if (wr == 1) PG8_BAR;
    PG8_WAIT_V(2); PG8_BAR;
    PG8_STAGE(PG8_SB(1, 0), cB + kstep, voffB); PG8_STAGE(PG8_SA(1, 0), cA + kstep, voffA); PG8_STAGE(PG8_SB(1, 1), cB + hstepB + kstep, voffB);
    PG8_WAIT_V(6); PG8_BAR;
    for (;;) {
        const bool has_next = S.next(ui + 1, nxt);
        const char* nA = has_next ? nxt.A : cA; const char* nB = has_next ? nxt.B : cB;
        for (int t = 0; t < nt; t += 2) {
            const bool last = (t == nt - 2);
            const char* a1 = cA + (size_t)(t + 1) * kstep;
            const char* a2 = last ? nA : cA + (size_t)(t + 2) * kstep; const char* b2 = last ? nB : cB + (size_t)(t + 2) * kstep;
            const char* a3 = a2 + kstep; const char* b3 = b2 + kstep;
            PG8_LDB(B0, 0, 0); PG8_LDB(B1, 0, 1); PG8_SCHED; PG8_LDA(At, 0, 0); PG8_STAGE(PG8_SA(1, 1), a1 + hstepA, voffA);
            PG8_WAIT_V(8); PG8_WAIT_L(0); PG8_BAR; PG8_MMA(0, 0, At, B0); PG8_MMA(0, 1, At, B1); PG8_BAR; PG8_SCHED;
            PG8_LDA(At, 0, 1); PG8_STAGE(PG8_SB(0, 0), b2, voffB); PG8_STAGE(PG8_SB(0, 1), b2 + hstepB, voffB); PG8_STAGE(PG8_SA(0, 0), a2, voffA);
            PG8_WAIT_V(8); PG8_WAIT_L(0); PG8_BAR; PG8_MMA(1, 0, At, B0); PG8_MMA(1, 1, At, B1); PG8_BAR; PG8_SCHED;
            PG8_LDB(B0, 1, 0); PG8_LDB(B1, 1, 1); PG8_SCHED; PG8_LDA(At, 1, 0); PG8_STAGE(PG8_SA(0, 1), a2 + hstepA, voffA);
            PG8_WAIT_V(8); PG8_WAIT_L(0); PG8_BAR; PG8_MMA(0, 0, At, B0); PG8_MMA(0, 1, At, B1); PG8_BAR; PG8_SCHED;
            PG8_LDA(At, 1, 1); PG8_STAGE(PG8_SB(1, 0), b3, voffB); PG8_STAGE(PG8_SB(1, 1), b3 + hstepB, voffB); PG8_STAGE(PG8_SA(1, 0), a3, voffA);
            PG8_WAIT_V(8); PG8_WAIT_L(0); PG8_BAR; PG8_MMA(1, 0, At, B0); PG8_MMA(1, 1, At, B1); PG8_BAR; PG8_SCHED;
        }
        if (wr == 0) PG8_BAR;
        E(acc, cur, wr, wc, fr, fq);
        if (EPIREP && !Epi::RMW) { asm volatile("" ::: "memory"); E(acc, cur, wr, wc, fr, fq); }
        if (!has_next) break;
        if (!(Epi::CHAIN && cur.z < 3)) {
#pragma unroll
        for (int a = 0; a < 2; ++a)
#pragma unroll
            for (int b = 0; b < 2; ++b)
#pragma unroll
                for (int m = 0; m < 4; ++m)
#pragma unroll
                    for (int n = 0; n < 2; ++n) acc[a][b][m][n] = (f32x4){0.f, 0.f, 0.f, 0.f};
        }
        cur = nxt; cA = nA; cB = nB; ++ui;
        if (wr == 1) PG8_BAR;
    }
    PG8_WAIT_V(0);
    PG8_BAR;
#undef PG8_SA
#undef PG8_SB
#undef PG8_STAGE
#undef PG8_LDA
#undef PG8_LDB
#undef PG8_MMA
#undef PG8_WAIT_V
#undef PG8_WAIT_L
#undef PG8_BAR
#undef PG8_SCHED
}
}

template <int MODE> __device__ __forceinline__ int colmap(int n) {
    if (MODE == 1) { if (n < 3584) return n; if (n < 9728) return n + 8; if (n < 9736) return 3584 + (n - 9728); return -1; }
    if (MODE == 2) { const int pn = n >> 8, bj = (n >> 7) & 1, i = n & 127; return bj * 512 + pn * 128 + i; }
    return n;
}
struct TrItem { const float* W; bf16_t* WT; int K, Nsrc, mode, k0, n0; };
__device__ __forceinline__ int colmap_rt(int mode, int n) { return mode == 1 ? colmap<1>(n) : (mode == 2 ? colmap<2>(n) : n); }
__device__ __forceinline__ TrItem tr_decode(const Params& p, int l, int it) {
    constexpr int I_IN = 16 * (NPROJ / 32), I_BR1 = 8 * 32, I_OUT = 16 * 32, I_UP = 16 * 128, I_DN = 64 * 32;
    TrItem t; int r = it, Ndst;
    if (r < I_IN) { t.W = p.in[2] + (size_t)l * 1024 * 9736; t.WT = (bf16_t*)(p.ws + WS_WIN); t.K = 1024; t.Nsrc = 9736; Ndst = NPROJ; t.mode = 1; }
    else if ((r -= I_IN) < 4 * I_BR1) { const int n = r / I_BR1; r -= n * I_BR1; t.W = p.in[3] + ((size_t)l * 4 + n) * 512 * 1024; t.WT = (bf16_t*)(p.ws + WS_WBR) + (size_t)n * 1024 * 512; t.K = 512; t.Nsrc = 1024; Ndst = 1024; t.mode = 0; }
    else if ((r -= 4 * I_BR1) < I_OUT) { t.W = p.in[4] + (size_t)l * 1024 * 1024; t.WT = (bf16_t*)(p.ws + WS_WOUT); t.K = 1024; t.Nsrc = 1024; Ndst = 1024; t.mode = 0; }
    else if ((r -= I_OUT) < I_UP) { t.W = p.in[9] + (size_t)l * 1024 * 4096; t.WT = (bf16_t*)(p.ws + WS_WUP); t.K = 1024; t.Nsrc = 4096; Ndst = 4096; t.mode = 0; }
    else if ((r -= I_UP) < I_DN) { t.W = p.in[10] + (size_t)l * 4096 * 1024; t.WT = (bf16_t*)(p.ws + WS_WDN); t.K = 4096; t.Nsrc = 1024; Ndst = 1024; t.mode = 0; }
    else { r -= I_DN; t.W = p.in[20] + (size_t)l * 512 * 1024; t.WT = (bf16_t*)(p.ws + WS_WGLU); t.K = 512; t.Nsrc = 1024; Ndst = 1024; t.mode = 2; }
    const int nblk = Ndst / 32, kb = r / nblk, nb = r - kb * nblk; t.k0 = 64 * kb; t.n0 = 32 * nb;
    return t;
}
__device__ __forceinline__ void tr_load(const TrItem& t, int lane, float (&v)[32]) {
    const int sc = colmap_rt(t.mode, t.n0 + (lane & 31));
    const float* src = t.W + (size_t)(t.k0 + (lane >> 5)) * t.Nsrc + (sc >= 0 ? sc : 0);
#pragma unroll
    for (int i = 0; i < 32; ++i) { const float x = __builtin_nontemporal_load(src + (size_t)(2 * i) * t.Nsrc); v[i] = sc >= 0 ? x : 0.f; }
}
__device__ __forceinline__ void convert_layer(const Params& p, int l, LAS unsigned char* lds) {
    const int tid__ = opaque_tid(); const int lane = tid__ & 63, wave = tid__ >> 6;
    LAS float* scr = (LAS float*)(lds + wave * 8448);
    const int gw = blockIdx.x * 8 + wave, NGW = gridDim.x * 8;
    constexpr int NIT = 16 * (NPROJ / 32) + 4 * 8 * 32 + 16 * 32 + 16 * 128 + 64 * 32 + 8 * 32;
    float v[32]; TrItem cur{};
    int it = gw;
    if (it < NIT) { cur = tr_decode(p, l, it); tr_load(cur, lane, v); }
    while (it < NIT) {
        const TrItem done = cur;
#pragma unroll
        for (int i = 0; i < 32; ++i) scr[(2 * i + (lane >> 5)) * 33 + (lane & 31)] = v[i];
        const int nxt = it + NGW;
        if (nxt < NIT) { cur = tr_decode(p, l, nxt); tr_load(cur, lane, v); }
        LDS_WAIT();
        const int c = lane & 7;
#pragma unroll
        for (int j = 0; j < 4; ++j) { const int n = (lane >> 3) + 8 * j; const LAS float* sp = scr + (8 * c) * 33 + n;
            u32x4 o; o.x = pk2(sp[0 * 33], sp[1 * 33]); o.y = pk2(sp[2 * 33], sp[3 * 33]); o.z = pk2(sp[4 * 33], sp[5 * 33]); o.w = pk2(sp[6 * 33], sp[7 * 33]);
            *(u32x4*)(done.WT + (size_t)(done.n0 + n) * done.K + done.k0 + 8 * c) = o; }
        LDS_WAIT();
        it = nxt;
    }
}

template <int MODE, bool FINAL> __device__ __forceinline__ void norm_phase(const Params& p, const float* wpost, const float* wpre) {
    const int tid__ = opaque_tid(); const int lane = tid__ & 63, wave = tid__ >> 6;
    const int gw = blockIdx.x * 8 + wave, NGW = gridDim.x * 8;
    float* H = (float*)(p.ws + WS_H); const bf16_t* DL = (const bf16_t*)(p.ws + WS_DELTA); bf16_t* U = (bf16_t*)(p.ws + WS_U);
    f32x4 hn[4]; u32x2 dn[4];
    auto src_of = [&](int row) -> const float* { const int b = row / TP, r = row - b * TP;
        if (MODE == 0) return r < 64 ? p.in[1] + (size_t)(r < PADF ? 0 : r - PADF) * 1024 : p.in[0] + ((size_t)b * SEQ + (r - 64)) * 1024;
        return H + (size_t)row * 1024; };
    auto load_row = [&](int row) { const float* src = src_of(row);
#pragma unroll
        for (int j = 0; j < 4; ++j) { hn[j] = *(const f32x4*)(src + 4 * lane + 256 * j); if (MODE == 1) dn[j] = *(const u32x2*)(DL + (size_t)row * 1024 + 4 * lane + 256 * j); } };
    if (gw < MROWS) load_row(gw);
    for (int row = gw; row < MROWS; row += NGW) {
        const int b = row / TP, r = row - b * TP; const bool pad = r < PADF;
        f32x4 hv[4], dv[4];
#pragma unroll
        for (int j = 0; j < 4; ++j) { hv[j] = hn[j]; if (MODE == 1) dv[j] = (f32x4){bflo(dn[j].x), bfhi(dn[j].x), bflo(dn[j].y), bfhi(dn[j].y)}; }
        if (row + NGW < MROWS) load_row(row + NGW);
        if (MODE == 0) {
#pragma unroll
            for (int j = 0; j < 4; ++j) if (pad) hv[j] = (f32x4){0.f, 0.f, 0.f, 0.f};
        } else {
            float ss = 0.f;
#pragma unroll
            for (int j = 0; j < 4; ++j) ss += (dv[j][0] * dv[j][0] + dv[j][1] * dv[j][1]) + (dv[j][2] * dv[j][2] + dv[j][3] * dv[j][3]);
            const float rstd = rsqrtf(wave_sum(ss) * (1.f / 1024.f) + EPS);
#pragma unroll
            for (int j = 0; j < 4; ++j) { const f32x4 w = *(const f32x4*)(wpost + 4 * lane + 256 * j); hv[j] = hv[j] + dv[j] * rstd * w; if (pad) hv[j] = (f32x4){0.f, 0.f, 0.f, 0.f}; }
        }
        if (FINAL) {
            if (r >= 64) {
#pragma unroll
                for (int j = 0; j < 4; ++j) *(f32x4*)(p.out + ((size_t)b * SEQ + (r - 64)) * 1024 + 4 * lane + 256 * j) = hv[j];
            }
        } else {
            float ss = 0.f;
#pragma unroll
            for (int j = 0; j < 4; ++j) { *(f32x4*)(H + (size_t)row * 1024 + 4 * lane + 256 * j) = hv[j]; ss += (hv[j][0] * hv[j][0] + hv[j][1] * hv[j][1]) + (hv[j][2] * hv[j][2] + hv[j][3] * hv[j][3]); }
            const float rstd = rsqrtf(wave_sum(ss) * (1.f / 1024.f) + EPS);
#pragma unroll
            for (int j = 0; j < 4; ++j) { const f32x4 w = *(const f32x4*)(wpre + 4 * lane + 256 * j); const f32x4 o = hv[j] * rstd * w;
                u32x2 q; q.x = pk2(o[0], o[1]); q.y = pk2(o[2], o[3]); *(u32x2*)(U + (size_t)row * 1024 + 4 * lane + 256 * j) = q; }
        }
    }
}

__device__ __forceinline__ void unpack8(const u32x4 w, float (&v)[8]) { v[0] = bflo(w.x); v[1] = bfhi(w.x); v[2] = bflo(w.y); v[3] = bfhi(w.y); v[4] = bflo(w.z); v[5] = bfhi(w.z); v[6] = bflo(w.w); v[7] = bfhi(w.w); }
__device__ __forceinline__ u32x4 pack8(const float (&v)[8]) { u32x4 w; w.x = pk2(v[0], v[1]); w.y = pk2(v[2], v[3]); w.z = pk2(v[4], v[5]); w.w = pk2(v[6], v[7]); return w; }
__device__ __forceinline__ void post_phase(const Params& p, int l) {
    const int tid__ = opaque_tid(); const int lane = tid__ & 63, wave = tid__ >> 6;
    const int gw = blockIdx.x * 8 + wave, NGW = gridDim.x * 8;
    bf16_t* BR = (bf16_t*)(p.ws + WS_BR); const bf16_t* MX = (const bf16_t*)(p.ws + WS_MX);
    const float* gnw = p.in[11] + l * 512 + lane * 8; const float* ssdw = p.in[27] + l * 512 + lane * 8; const float* hgw = p.in[29] + l * 512 + lane * 8;
    u32x4 n0, n1, n2, n3, n4;
    auto load_row = [&](int row) { const bf16_t* br = BR + (size_t)row * LDBR + lane * 8; const bf16_t* mx = MX + (size_t)row * LDMX + lane * 8;
        n0 = *(const u32x4*)br; n1 = *(const u32x4*)(mx + RG); n2 = *(const u32x4*)(br + 1024); n3 = *(const u32x4*)(br + 1536); n4 = *(const u32x4*)(mx + HGT); };
    if (gw < MROWS) load_row(gw);
    for (int row = gw; row < MROWS; row += NGW) {
        bf16_t* br = BR + (size_t)row * LDBR + lane * 8;
        const u32x4 c0 = n0, c1 = n1, c2 = n2, c3 = n3, c4 = n4;
        if (row + NGW < MROWS) load_row(row + NGW);
        float y[8], g[8];
        {
            unpack8(c0, y); unpack8(c1, g);
            float s = 0.f;
#pragma unroll
            for (int j = 0; j < 8; ++j) s += y[j];
            s += __shfl_xor(s, 1); s += __shfl_xor(s, 2); s += __shfl_xor(s, 4); s += __shfl_xor(s, 8);
            const float mu = s * (1.f / 128.f); float v = 0.f;
#pragma unroll
            for (int j = 0; j < 8; ++j) { y[j] -= mu; v += y[j] * y[j]; }
            v += __shfl_xor(v, 1); v += __shfl_xor(v, 2); v += __shfl_xor(v, 4); v += __shfl_xor(v, 8);
            const float rstd = rsqrtf(v * (1.f / 128.f) + EPS);
#pragma unroll
            for (int j = 0; j < 8; ++j) y[j] = siluf_(g[j]) * (y[j] * rstd * gnw[j]);
            *(u32x4*)br = pack8(y);
        }
        {
            unpack8(c2, y);
            float v = 0.f;
#pragma unroll
            for (int j = 0; j < 8; ++j) v += y[j] * y[j];
            v += __shfl_xor(v, 1); v += __shfl_xor(v, 2); v += __shfl_xor(v, 4); v += __shfl_xor(v, 8); v += __shfl_xor(v, 16);
            const float rstd = rsqrtf(v * (1.f / 256.f) + EPS);
#pragma unroll
            for (int j = 0; j < 8; ++j) y[j] = y[j] * rstd * ssdw[j];
            *(u32x4*)(br + 1024) = pack8(y);
        }
        {
            unpack8(c3, y); unpack8(c4, g);
            float v = 0.f;
#pragma unroll
            for (int j = 0; j < 8; ++j) v += y[j] * y[j];
            v += __shfl_xor(v, 1); v += __shfl_xor(v, 2); v += __shfl_xor(v, 4); v += __shfl_xor(v, 8);
            const float rstd = rsqrtf(v * (1.f / 128.f) + EPS);
#pragma unroll
            for (int j = 0; j < 8; ++j) y[j] = y[j] * rstd * hgw[j] * siluf_(g[j]);
            *(u32x4*)(br + 1536) = pack8(y);
        }
    }
}

__device__ __forceinline__ void conv_phase(const Params& p, int l) {
    const int tid = opaque_tid();
    const bf16_t* MX = (const bf16_t*)(p.ws + WS_MX); bf16_t* XBC = (bf16_t*)(p.ws + WS_XBC);
    const int NT = NB * (TP / 8) * 128;
    for (int task = blockIdx.x * 512 + tid; task < NT; task += gridDim.x * 512) {
        const int cg8 = task & 127, rb = (task >> 7) % (TP / 8), b = (task >> 7) / (TP / 8), ch0 = cg8 * 8, r0 = rb * 8;
        if (b > 0 && r0 < 64) continue;
        bf16_t* dst = XBC + ((size_t)b * TP + r0) * 1024 + ch0;
        if (r0 < PADF) {
#pragma unroll
            for (int i = 0; i < 8; ++i) *(u32x4*)(dst + (size_t)i * 1024) = (u32x4){0u, 0u, 0u, 0u};
            continue; }
        float cw[4][8], cb[8], win[3][8];
#pragma unroll
        for (int j = 0; j < 4; ++j) { const f32x4 x0 = *(const f32x4*)(p.in[22] + (size_t)(l * 4 + j) * 1024 + ch0), x1 = *(const f32x4*)(p.in[22] + (size_t)(l * 4 + j) * 1024 + ch0 + 4);
            cw[j][0] = x0[0]; cw[j][1] = x0[1]; cw[j][2] = x0[2]; cw[j][3] = x0[3]; cw[j][4] = x1[0]; cw[j][5] = x1[1]; cw[j][6] = x1[2]; cw[j][7] = x1[3]; }
        { const f32x4 x0 = *(const f32x4*)(p.in[23] + l * 1024 + ch0), x1 = *(const f32x4*)(p.in[23] + l * 1024 + ch0 + 4);
          cb[0] = x0[0]; cb[1] = x0[1]; cb[2] = x0[2]; cb[3] = x0[3]; cb[4] = x1[0]; cb[5] = x1[1]; cb[6] = x1[2]; cb[7] = x1[3]; }
        u32x4 raw[11];
#pragma unroll
        for (int k = 0; k < 11; ++k) { const int r = r0 - 3 + k; raw[k] = *(const u32x4*)(MX + (r < 64 ? (size_t)r : (size_t)b * TP + r) * LDMX + SXBC + ch0); }
#pragma unroll
        for (int k = 0; k < 3; ++k) unpack8(raw[k], win[k]);
#pragma unroll
        for (int i = 0; i < 8; ++i) { float cur[8], o[8]; unpack8(raw[3 + i], cur);
#pragma unroll
            for (int j = 0; j < 8; ++j) { o[j] = siluf_(cb[j] + cw[0][j] * win[0][j] + cw[1][j] * win[1][j] + cw[2][j] * win[2][j] + cw[3][j] * cur[j]); win[0][j] = win[1][j]; win[1][j] = win[2][j]; win[2][j] = cur[j]; }
            *(u32x4*)(dst + (size_t)i * 1024) = pack8(o); }
    }
}
__device__ __forceinline__ float hgrn_lb(const Params& p, int l, int ch) {
    const float* lb = p.in[28];
    const float v0 = lb[ch], v1 = lb[512 + ch], v2 = lb[1024 + ch], v3 = lb[1536 + ch];
    const float m = fmaxf(fmaxf(v0, v1), fmaxf(v2, v3));
    const float e0 = __expf(v0 - m), e1 = __expf(v1 - m), e2 = __expf(v2 - m), e3 = __expf(v3 - m);
    const float inv = 1.f / (e0 + e1 + e2 + e3);
    float acc = 0.f;
    if (l >= 1) acc += e1; if (l >= 2) acc += e2; if (l >= 3) acc += e3;
    return acc * inv;
}

__device__ __forceinline__ void s5_simple(const Params& p, int l, int unit) {
    const int lane = opaque_tid() & 63; const int b = unit >> 5, g = unit & 31;
    const bf16_t* MX = (const bf16_t*)(p.ws + WS_MX); bf16_t* S5P = (bf16_t*)(p.ws + WS_S5P);
    const int gp = (l * 32 + g) * 64 + lane;
    const float step = expf(p.in[19][l * 32 + g]), lr = p.in[12][gp], li = p.in[13][gp];
    const float mag = expf(lr * step); float sn, cs; sincos_turns(li * step * 0.15915494309f, sn, cs);
    const float ar = mag * cs, ai = mag * sn, inv = 1.f / (lr * lr + li * li);
    const float cor = ((ar - 1.f) * lr + ai * li) * inv, coi = (ai * lr - (ar - 1.f) * li) * inv;
    float bbr[16], bbi[16], cre[16], cim[16];
#pragma unroll
    for (int j = 0; j < 16; ++j) { const float br = p.in[14][(size_t)gp * 16 + j], bi = p.in[15][(size_t)gp * 16 + j]; bbr[j] = cor * br - coi * bi; bbi[j] = cor * bi + coi * br;
        cre[j] = p.in[16][((size_t)(l * 32 + g) * 16 + j) * 64 + lane]; cim[j] = p.in[17][((size_t)(l * 32 + g) * 16 + j) * 64 + lane]; }
    const float dsk = p.in[18][l * 512 + g * 16 + (lane & 15)];
    float xr = 0.f, xi = 0.f;
    for (int r = PADF; r < TP; ++r) {
        const size_t row = (size_t)b * TP + r;
        const float uv = bf2f(MX[row * LDMX + S5U + g * 16 + (lane & 15)]);
        float bur = 0.f, bui = 0.f;
#pragma unroll
        for (int j = 0; j < 16; ++j) { const float uj = __shfl(uv, j); bur += bbr[j] * uj; bui += bbi[j] * uj; }
        const float nxr = ar * xr - ai * xi + bur, nxi = ar * xi + ai * xr + bui; xr = nxr; xi = nxi;
        float yv = 0.f;
#pragma unroll
        for (int j = 0; j < 16; ++j) { const float s = wave_sum(xr * cre[j] - xi * cim[j]); yv = (lane == j) ? s : yv; }
        if (lane < 16) { const float y = yv + dsk * uv; S5P[row * 512 + g * 16 + lane] = (bf16_t)f2bf(geluf_(y)); }
    }
}
__device__ __forceinline__ void ret_simple(const Params& p, int l, int unit) {
    const int lane = opaque_tid() & 63; const int b = unit >> 3, hd = (unit >> 1) & 3, eh = unit & 1;
    const bf16_t* MX = (const bf16_t*)(p.ws + WS_MX); bf16_t* BR = (bf16_t*)(p.ws + WS_BR);
    const float gamma = 1.f - exp2f(-5.f - (float)hd);
    const int i = lane & 31; const float invf_t = exp2f(-(float)i * (13.287712379549449f / 32.f)) * 0.15915494309f;
    float h[64];
#pragma unroll
    for (int d = 0; d < 64; ++d) h[d] = 0.f;
    for (int r = PADF; r < TP; ++r) {
        const size_t row = (size_t)b * TP + r; const bf16_t* mx = MX + row * LDMX;
        float sn, cs; sincos_turns((float)(r - PADF) * invf_t, sn, cs);
        const float q1 = bf2f(mx[RQ + hd * 64 + i]), q2 = bf2f(mx[RQ + hd * 64 + 32 + i]), k1 = bf2f(mx[RK + hd * 64 + i]), k2 = bf2f(mx[RK + hd * 64 + 32 + i]);
        const float qr = lane < 32 ? q1 * cs - q2 * sn : q1 * sn + q2 * cs;
        const float kr = (lane < 32 ? k1 * cs - k2 * sn : k1 * sn + k2 * cs) * 0.125f;
        const float v = bf2f(mx[RV + hd * 128 + eh * 64 + lane]);
        float y = 0.f;
#pragma unroll
        for (int d = 0; d < 64; ++d) { const float kd = __shfl(kr, d), qd = __shfl(qr, d); h[d] = gamma * h[d] + kd * v; y += h[d] * qd; }
        BR[row * LDBR + hd * 128 + eh * 64 + lane] = (bf16_t)f2bf(y);
    }
}
__device__ __forceinline__ void ssd_simple(const Params& p, int l, int unit, LAS unsigned char* lds) {
    const int tid = opaque_tid(), lane = tid & 63, w = tid >> 6; const int b = unit >> 3, hd = unit & 7, g = hd >> 2;
    const bf16_t* MX = (const bf16_t*)(p.ws + WS_MX); bf16_t* BR = (bf16_t*)(p.ws + WS_BR); const bf16_t* DT = (const bf16_t*)(p.ws + WS_DT);
    LAS float* xs_s = (LAS float*)lds; LAS float* B_s = xs_s + 64; LAS float* C_s = B_s + 128; LAS float* dt_s = C_s + 128; LAS float* part = dt_s + 64;
    const float a = -expf(p.in[25][l * 8 + hd]), dtb = p.in[24][l * 8 + hd], Dh = p.in[26][l * 8 + hd];
    int ch = 0; float cw[4] = {0.f, 0.f, 0.f, 0.f}, cb = 0.f;
    if (tid < 320) { ch = tid < 64 ? hd * 64 + tid : (tid < 192 ? 512 + g * 128 + (tid - 64) : 768 + g * 128 + (tid - 192));
#pragma unroll
        for (int j = 0; j < 4; ++j) cw[j] = p.in[22][(size_t)(l * 4 + j) * 1024 + ch];
        cb = p.in[23][l * 1024 + ch]; }
    float h[16];
#pragma unroll
    for (int i = 0; i < 16; ++i) h[i] = 0.f;
    for (int r = PADF; r < TP; ++r) {
        const size_t row = (size_t)b * TP + r;
        if (tid < 320) { float o = cb;
#pragma unroll
            for (int j = 0; j < 4; ++j) o += cw[j] * bf2f(MX[(row - 3 + j) * LDMX + SXBC + ch]);
            o = siluf_(o); if (tid < 64) xs_s[tid] = o; else if (tid < 192) B_s[tid - 64] = o; else C_s[tid - 192] = o; }
        if (tid == 320) dt_s[0] = softplusf_(bf2f(DT[row * LDDT + hd]) + dtb);
        __syncthreads();
        const float dt = dt_s[0], da = __expf(dt * a), xv = xs_s[lane] * dt; float pt = 0.f;
#pragma unroll
        for (int i = 0; i < 16; ++i) { h[i] = da * h[i] + B_s[w * 16 + i] * xv; pt += h[i] * C_s[w * 16 + i]; }
        part[w * 64 + lane] = pt;
        __syncthreads();
        if (tid < 64) { float y = 0.f;
#pragma unroll
            for (int k = 0; k < 8; ++k) y += part[k * 64 + tid];
            y += Dh * xs_s[tid]; const float z = bf2f(MX[row * LDMX + SZ + hd * 64 + tid]);
            BR[row * LDBR + 1024 + hd * 64 + tid] = (bf16_t)f2bf(y * siluf_(z)); }
        __syncthreads();
    }
}
__device__ __forceinline__ void hg_simple(const Params& p, int l, int unit, LAS unsigned char* lds) {
    const int tid = opaque_tid(), e = tid & 127, dq = tid >> 7; const int b = unit >> 2, hd = unit & 3;
    const bf16_t* MX = (const bf16_t*)(p.ws + WS_MX); bf16_t* BR = (bf16_t*)(p.ws + WS_BR);
    LAS float* f_s = (LAS float*)lds; LAS float* k_s = f_s + 128; LAS float* q_s = k_s + 128; LAS float* v_s = q_s + 128; LAS float* part = v_s + 128;
    const float lb = hgrn_lb(p, l, hd * 128 + e);
    float h[32];
#pragma unroll
    for (int i = 0; i < 32; ++i) h[i] = 0.f;
    for (int r = PADF; r < TP; ++r) {
        const size_t row = (size_t)b * TP + r; const bf16_t* mx = MX + row * LDMX;
        if (tid < 128) { const float qraw = bf2f(mx[HQ + hd * 128 + tid]), fraw = bf2f(mx[HF + hd * 128 + tid]); const float f = lb + (1.f - lb) * sigmoidf_(fraw);
            f_s[tid] = f; k_s[tid] = 1.f - f; q_s[tid] = siluf_(qraw); }
        else if (tid < 256) v_s[tid - 128] = bf2f(mx[HI + hd * 128 + (tid - 128)]);
        __syncthreads();
        const float v = v_s[e]; float pt = 0.f;
#pragma unroll
        for (int i = 0; i < 32; ++i) { const int d = dq * 32 + i; h[i] = f_s[d] * h[i] + k_s[d] * v; pt += h[i] * q_s[d]; }
        part[dq * 128 + e] = pt;
        __syncthreads();
        if (tid < 128) BR[row * LDBR + 1536 + hd * 128 + tid] = (bf16_t)f2bf(part[tid] + part[128 + tid] + part[256 + tid] + part[384 + tid]);
        __syncthreads();
    }
}


__device__ __forceinline__ bf16x8 ldfrag(const LAS bf16_t* base, int row, int stride, int k) { return *(const LAS bf16x8*)(base + row * stride + k); }
#define MFMA16(a, b, c) __builtin_amdgcn_mfma_f32_16x16x32_bf16(a, b, c, 0, 0, 0)

template <int NT>
__device__ __forceinline__ void meta_tiles(LAS unsigned char* lds, const bf16_t* const (&Ap)[NT], int lda, const bf16_t* const (&Bp)[NT], int ldb, int K, int w, int lane, f32x4 (&out)[NT]) {
    const int r16 = lane & 15, q4 = lane >> 4, ks = K >> 3;
    f32x4 acc[NT][4];
#pragma unroll
    for (int t = 0; t < NT; ++t)
#pragma unroll
        for (int m = 0; m < 4; ++m) acc[t][m] = (f32x4){0.f, 0.f, 0.f, 0.f};
#pragma unroll
    for (int t = 0; t < NT; ++t) {
        const bf16_t* bp = Bp[t] + (size_t)r16 * ldb + w * ks + q4 * 8; const bf16_t* ap = Ap[t] + (size_t)r16 * lda + w * ks + q4 * 8;
#pragma unroll 4
        for (int k0 = 0; k0 < ks; k0 += 32) { const bf16x8 bfr = *(const bf16x8*)(bp + k0);
#pragma unroll
            for (int m = 0; m < 4; ++m) acc[t][m] = MFMA16(bfr, *(const bf16x8*)(ap + (size_t)m * 16 * lda + k0), acc[t][m]); } }
    LAS f32x4* red = (LAS f32x4*)lds;
    __syncthreads();
#pragma unroll
    for (int t = 0; t < NT; ++t)
#pragma unroll
        for (int m = 0; m < 4; ++m) red[((w * NT + t) * 4 + m) * 64 + lane] = acc[t][m];
    __syncthreads();
#pragma unroll
    for (int t = 0; t < NT; ++t) { f32x4 v = (f32x4){0.f, 0.f, 0.f, 0.f};
        if (w < 4) {
#pragma unroll
            for (int ww = 0; ww < 8; ++ww) v = v + red[((ww * NT + t) * 4 + w) * 64 + lane]; }
        out[t] = v; }
}
__device__ __forceinline__ f32x4 meta_tile(LAS unsigned char* lds, const bf16_t* A, int lda, const bf16_t* Bt, int ldb, int K, int brow0, int w, int lane) {
    const bf16_t* const Ap[1] = {A}; const bf16_t* const Bp[1] = {Bt + (size_t)brow0 * ldb}; f32x4 o[1];
    meta_tiles<1>(lds, Ap, lda, Bp, ldb, K, w, lane, o); return o[0];
}

#define META_IDS() const int tid = opaque_tid(), lane = tid & 63, w = __builtin_amdgcn_readfirstlane(tid >> 6), r16 = lane & 15, q4 = lane >> 4; const int row = w * 16 + r16; (void)row; (void)q4
__device__ __forceinline__ void meta_proj(const Params& p, LAS unsigned char* lds) {
    META_IDS();
    const bf16_t* U = (const bf16_t*)(p.ws + WS_U); const bf16_t* W = (const bf16_t*)(p.ws + WS_WIN);
    bf16_t* MX = (bf16_t*)(p.ws + WS_MX); bf16_t* G = (bf16_t*)(p.ws + WS_G); bf16_t* DT = (bf16_t*)(p.ws + WS_DT);
    const int mj0 = gridDim.x == 256 ? (int)blockIdx.x - 192 : (int)blockIdx.x, mjs = gridDim.x == 256 ? 64 : (int)gridDim.x;
    if (mj0 >= 0) for (int jq = mj0; jq < NPROJ / 64; jq += mjs) {
        const bf16_t* const Ap[4] = {U, U, U, U};
        const bf16_t* const Bp[4] = {W + (size_t)(jq * 64) * 1024, W + (size_t)(jq * 64 + 16) * 1024, W + (size_t)(jq * 64 + 32) * 1024, W + (size_t)(jq * 64 + 48) * 1024};
        f32x4 vq[4]; meta_tiles<4>(lds, Ap, 1024, Bp, 1024, 1024, w, lane, vq);
        if (w < 4) {
#pragma unroll
            for (int t = 0; t < 4; ++t) { const f32x4 v = vq[t]; const int col = jq * 64 + t * 16 + q4 * 4;
                if (col >= 5632 && col < 9728) *(unsigned*)((unsigned char*)G + (size_t)row * LDG + (col - 5632)) = gate_q8x4(v[0], v[1], v[2], v[3]);
                else { bf16_t* dst = col < 5632 ? MX + (size_t)row * LDMX + col : DT + (size_t)row * LDDT + (col - 9728);
                    *(u32x2*)dst = (u32x2){pk2(v[0], v[1]), pk2(v[2], v[3])}; } } } }
}
__device__ __forceinline__ void meta_glu(const Params& p, int l, LAS unsigned char* lds) {
    META_IDS();
    const bf16_t* A = (const bf16_t*)(p.ws + WS_S5P); const bf16_t* W = (const bf16_t*)(p.ws + WS_WGLU); bf16_t* BR = (bf16_t*)(p.ws + WS_BR);
    for (int j = blockIdx.x; j < 32; j += gridDim.x) { const int oc0 = j * 16, arow0 = (oc0 >> 7) * 256 + (oc0 & 127);
        const bf16_t* const Ap[2] = {A, A}; const bf16_t* const Bp[2] = {W + (size_t)arow0 * 512, W + (size_t)(arow0 + 128) * 512}; f32x4 vv[2];
        meta_tiles<2>(lds, Ap, 512, Bp, 512, 512, w, lane, vv); const f32x4 va = vv[0], vg = vv[1];
        if (w < 4) { const int oc = oc0 + q4 * 4; const f32x4 ba = *(const f32x4*)(p.in[21] + l * 1024 + oc), bg = *(const f32x4*)(p.in[21] + l * 1024 + 512 + oc);
            f32x4 o;
#pragma unroll
            for (int i = 0; i < 4; ++i) o[i] = (va[i] + ba[i]) * sigmoidf_(vg[i] + bg[i]);
            *(u32x2*)(BR + (size_t)row * LDBR + 512 + oc) = (u32x2){pk2(o[0], o[1]), pk2(o[2], o[3])}; } }
}
__device__ __forceinline__ void meta_merge(const Params& p, LAS unsigned char* lds) {
    META_IDS();
    const bf16_t* BR = (const bf16_t*)(p.ws + WS_BR); const bf16_t* W = (const bf16_t*)(p.ws + WS_WBR); const bf16_t* G = (const bf16_t*)(p.ws + WS_G); bf16_t* O = (bf16_t*)(p.ws + WS_MIXP);
    for (int j = blockIdx.x; j < 64; j += gridDim.x) { f32x4 tot = (f32x4){0.f, 0.f, 0.f, 0.f}; const int col = j * 16 + q4 * 4;
        const bf16_t* const Ap[4] = {BR, BR + 512, BR + 1024, BR + 1536};
        const bf16_t* const Bp[4] = {W + (size_t)(j * 16) * 512, W + ((size_t)1024 + j * 16) * 512, W + ((size_t)2048 + j * 16) * 512, W + ((size_t)3072 + j * 16) * 512};
        f32x4 vz[4]; meta_tiles<4>(lds, Ap, LDBR, Bp, 512, 512, w, lane, vz);
#pragma unroll
        for (int z = 0; z < 4; ++z) { const f32x4 v = vz[z];
            if (w < 4) { const unsigned gw = *(const unsigned*)((const unsigned char*)G + (size_t)row * LDG + z * 1024 + col);
                tot = tot + (f32x4){gate_s(gw, 0), gate_s(gw, 1), gate_s(gw, 2), gate_s(gw, 3)} * (1.f / 256.f) * v; } }
        if (w < 4) *(u32x2*)(O + (size_t)row * 1024 + col) = (u32x2){pk2(tot[0], tot[1]), pk2(tot[2], tot[3])}; }
}
__device__ __forceinline__ void meta_f32(const Params& p, const bf16_t* A, int K, const bf16_t* W, LAS unsigned char* lds) {
    META_IDS();
    bf16_t* D = (bf16_t*)(p.ws + WS_DELTA);
    for (int j = blockIdx.x; j < 64; j += gridDim.x) { const f32x4 v = meta_tile(lds, A, K, W, K, K, j * 16, w, lane);
        if (w < 4) *(u32x2*)(D + (size_t)row * 1024 + j * 16 + q4 * 4) = (u32x2){pk2(v[0], v[1]), pk2(v[2], v[3])}; }
}
__device__ __forceinline__ void meta_up(const Params& p, LAS unsigned char* lds) {
    META_IDS();
    const bf16_t* U = (const bf16_t*)(p.ws + WS_U); const bf16_t* W = (const bf16_t*)(p.ws + WS_WUP); bf16_t* O = (bf16_t*)(p.ws + WS_G);
    for (int j = blockIdx.x; j < 256; j += gridDim.x) { f32x4 v = meta_tile(lds, U, 1024, W, 1024, 1024, j * 16, w, lane);
        if (w < 4) {
#pragma unroll
            for (int i = 0; i < 4; ++i) { const float a = fmaxf(v[i], 0.f); v[i] = a * a; }
            *(u32x2*)(O + (size_t)row * DFF + j * 16 + q4 * 4) = (u32x2){pk2(v[0], v[1]), pk2(v[2], v[3])}; } }
}
constexpr int A_QS = 0, A_KS = 17408, A_QX = 34816, A_KT = 52224, A_VT = 70656, A_PP = 79872, A_ST0 = 89088, A_ST1 = 106496, A_XS = 123904, A_CUM = 133120, A_DEC = 133632, A_TOT = 134144, A_DTA = 136192, A_CUMA = 144640;
static_assert(A_CUMA + 2112 * 4 + 16 <= LDS_BYTES, "lds");

template <int MODE>
__device__ __forceinline__ void attn_unit(const Params& p, int l, int unit, LAS unsigned char* lds) {
    constexpr int DK = MODE == 0 ? 64 : 128, SD = DK + 8, ST = 72, TPW = DK / 32;
    const int tid = opaque_tid(), lane = tid & 63, w = __builtin_amdgcn_readfirstlane(tid >> 6), r16 = lane & 15, q4 = lane >> 4;
    const int b = unit >> 3, hd = MODE == 1 ? (unit & 7) : ((unit >> 1) & 3), half = MODE == 1 ? 0 : (unit & 1), g = hd >> 2;
    const bf16_t* MX = (const bf16_t*)(p.ws + WS_MX); bf16_t* BR = (bf16_t*)(p.ws + WS_BR); const bf16_t* DT = (const bf16_t*)(p.ws + WS_DT); const bf16_t* XBC = (const bf16_t*)(p.ws + WS_XBC);
    LAS bf16_t* QS = (LAS bf16_t*)(lds + A_QS); LAS bf16_t* KS = (LAS bf16_t*)(lds + A_KS); LAS bf16_t* QX = (LAS bf16_t*)(lds + A_QX); LAS bf16_t* KT = (LAS bf16_t*)(lds + A_KT);
    LAS bf16_t* VT = (LAS bf16_t*)(lds + A_VT); LAS bf16_t* PP = (LAS bf16_t*)(lds + A_PP); LAS bf16_t* XS = (LAS bf16_t*)(lds + A_XS);
    LAS float* CUM0 = (LAS float*)(lds + A_CUM); LAS float* DEC = (LAS float*)(lds + A_DEC); LAS float* TOT = (LAS float*)(lds + A_TOT);
    LAS float* DTA = (LAS float*)(lds + A_DTA); LAS float* CUMA = (LAS float*)(lds + A_CUMA);
    float lg = 0.f, Dh = 0.f, lbv = 0.f; float invf_t[4] = {0.f, 0.f, 0.f, 0.f};
    if (MODE == 0) { lg = logf(1.f - exp2f(-5.f - (float)hd));
#pragma unroll
        for (int j = 0; j < 4; ++j) invf_t[j] = exp2f(-(float)((tid & 7) * 4 + j) * (13.287712379549449f / 32.f)) * 0.15915494309f; }
    if (MODE == 2) lbv = hgrn_lb(p, l, hd * 128 + (tid & 127));
    const int VBASE = MODE == 0 ? RV + hd * 128 + half * 64 : HI + hd * 128 + half * 64;
    const int OBASE = MODE == 0 ? hd * 128 + half * 64 : (MODE == 1 ? 1024 + hd * 64 : 1536 + hd * 128 + half * 64);
    __syncthreads();
    if (MODE == 1) {
        Dh = p.in[26][l * 8 + hd];
        const float a_h = -expf(p.in[25][l * 8 + hd]), dtb = p.in[24][l * 8 + hd];
        for (int r = tid; r < TP; r += 512) { const float dt = softplusf_(bf2f(DT[(r < 64 ? (size_t)r : (size_t)b * TP + r) * LDDT + hd]) + dtb); DTA[r] = dt; CUMA[r] = r < PADF ? 0.f : dt * a_h; }
        __syncthreads();
        for (int c = w; c < 33; c += 8) { float cum = CUMA[c * 64 + lane];
#pragma unroll
            for (int o = 1; o < 64; o <<= 1) { const float v = __shfl_up(cum, o); if (lane >= o) cum += v; }
            CUMA[c * 64 + lane] = cum; }
    } else { if (tid < 64) CUM0[tid] = MODE == 0 ? (float)(tid + 1) * lg : 0.f; }
    for (int i = tid; i < 64 * SD / 2; i += 512) ((LAS unsigned*)(lds + A_ST0))[i] = 0u;
    f32x4 st[TPW];
#pragma unroll
    for (int i = 0; i < TPW; ++i) st[i] = (f32x4){0.f, 0.f, 0.f, 0.f};
    u32x2 rq[4]; u32x4 rv; unsigned short hq[16], hf[16]; u32x4 rrow[6];
    auto load_raw = [&](int c) {
        const size_t row0 = c == 0 ? (size_t)0 : (size_t)b * TP + c * 64;
        if (MODE == 0) { const int t = tid >> 3, i0 = (tid & 7) * 4; const bf16_t* mx = MX + (row0 + t) * LDMX;
            rq[0] = *(const u32x2*)(mx + RQ + hd * 64 + i0); rq[1] = *(const u32x2*)(mx + RQ + hd * 64 + 32 + i0); rq[2] = *(const u32x2*)(mx + RK + hd * 64 + i0); rq[3] = *(const u32x2*)(mx + RK + hd * 64 + 32 + i0); }
        if (MODE == 2) { const int d = tid & 127, tq = tid >> 7;
#pragma unroll
            for (int i = 0; i < 16; ++i) { const bf16_t* mx = MX + (row0 + tq * 16 + i) * LDMX; hq[i] = mx[HQ + hd * 128 + d]; hf[i] = mx[HF + hd * 128 + d]; } }
        if (MODE == 0 || MODE == 2) { const int t = tid >> 3, e0 = (tid & 7) * 8; rv = *(const u32x4*)(MX + (row0 + t) * LDMX + VBASE + e0); }
        if (MODE == 1) {
#pragma unroll
            for (int k = 0; k < 3; ++k) { const int pt = tid + 512 * k; if (pt < 1280) { const int cgq = pt >> 5, u = pt & 31;
                const int chq = cgq < 8 ? hd * 64 + cgq * 8 : (cgq < 24 ? 512 + g * 128 + (cgq - 8) * 8 : 768 + g * 128 + (cgq - 24) * 8);
                rrow[2 * k] = *(const u32x4*)(XBC + (row0 + 2 * u) * 1024 + chq); rrow[2 * k + 1] = *(const u32x4*)(XBC + (row0 + 2 * u + 1) * 1024 + chq); } } }
    };
    __syncthreads();
    load_raw(0);
    for (int c = 0; c < 33; ++c) {
        const size_t row0 = (size_t)b * TP + c * 64;
        const LAS bf16_t* STc = (const LAS bf16_t*)(lds + ((c & 1) ? A_ST1 : A_ST0)); LAS bf16_t* STn = (LAS bf16_t*)(lds + ((c & 1) ? A_ST0 : A_ST1));
        const LAS float* CUM = MODE == 1 ? (const LAS float*)(CUMA + c * 64) : (const LAS float*)CUM0;
        u32x2 zw[2];
        if (MODE == 1) {
#pragma unroll
            for (int i = 0; i < 2; ++i) { const int ti = w * 2 + i, mt = ti >> 2, nt = ti & 3; zw[i] = *(const u32x2*)(MX + ((c == 0 ? (size_t)0 : row0) + mt * 16 + r16) * LDMX + SZ + hd * 64 + nt * 16 + q4 * 4); } }
        if (MODE == 0) {
            const int t = tid >> 3, i0 = (tid & 7) * 4;
            const float q1[4] = {bflo(rq[0].x), bfhi(rq[0].x), bflo(rq[0].y), bfhi(rq[0].y)}, q2[4] = {bflo(rq[1].x), bfhi(rq[1].x), bflo(rq[1].y), bfhi(rq[1].y)};
            const float k1[4] = {bflo(rq[2].x), bfhi(rq[2].x), bflo(rq[2].y), bfhi(rq[2].y)}, k2[4] = {bflo(rq[3].x), bfhi(rq[3].x), bflo(rq[3].y), bfhi(rq[3].y)};
            const float pos = (float)(c * 64 + t - PADF), eq = __expf((float)(t + 1) * lg), ek = __expf((float)(63 - t) * lg);
            float a1[4], a2[4], b1[4], b2[4];
#pragma unroll
            for (int j = 0; j < 4; ++j) { float sn, cs; sincos_turns(pos * invf_t[j], sn, cs);
                a1[j] = q1[j] * cs - q2[j] * sn; a2[j] = q1[j] * sn + q2[j] * cs; b1[j] = (k1[j] * cs - k2[j] * sn) * 0.125f; b2[j] = (k1[j] * sn + k2[j] * cs) * 0.125f; }
            *(LAS u32x2*)(QS + t * SD + i0) = (u32x2){pk2(a1[0], a1[1]), pk2(a1[2], a1[3])}; *(LAS u32x2*)(QS + t * SD + 32 + i0) = (u32x2){pk2(a2[0], a2[1]), pk2(a2[2], a2[3])};
            *(LAS u32x2*)(QX + t * SD + i0) = (u32x2){pk2(a1[0] * eq, a1[1] * eq), pk2(a1[2] * eq, a1[3] * eq)}; *(LAS u32x2*)(QX + t * SD + 32 + i0) = (u32x2){pk2(a2[0] * eq, a2[1] * eq), pk2(a2[2] * eq, a2[3] * eq)};
            *(LAS u32x2*)(KS + t * SD + i0) = (u32x2){pk2(b1[0], b1[1]), pk2(b1[2], b1[3])}; *(LAS u32x2*)(KS + t * SD + 32 + i0) = (u32x2){pk2(b2[0], b2[1]), pk2(b2[2], b2[3])};
#pragma unroll
            for (int j = 0; j < 4; ++j) { KT[(i0 + j) * ST + t] = (bf16_t)f2bf(b1[j] * ek); KT[(32 + i0 + j) * ST + t] = (bf16_t)f2bf(b2[j] * ek); }
        }
        if (MODE == 0 || MODE == 2) {
            const int t = tid >> 3, e0 = (tid & 7) * 8; const u32x4 vw = rv;
            VT[(e0 + 0) * ST + t] = (bf16_t)(vw.x & 0xffffu); VT[(e0 + 1) * ST + t] = (bf16_t)(vw.x >> 16); VT[(e0 + 2) * ST + t] = (bf16_t)(vw.y & 0xffffu); VT[(e0 + 3) * ST + t] = (bf16_t)(vw.y >> 16);
            VT[(e0 + 4) * ST + t] = (bf16_t)(vw.z & 0xffffu); VT[(e0 + 5) * ST + t] = (bf16_t)(vw.z >> 16); VT[(e0 + 6) * ST + t] = (bf16_t)(vw.w & 0xffffu); VT[(e0 + 7) * ST + t] = (bf16_t)(vw.w >> 16);
        }
        if (MODE == 2) {
            const int d = tid & 127, tq = tid >> 7;
            float lp[16], kv[16], qv[16]; float run = 1.f; const float oml = 1.f - lbv; const bool padchunk = c == 0;
#pragma unroll
            for (int i = 0; i < 16; ++i) { const int t = tq * 16 + i;
                const float qraw = bf2f(hq[i]), fraw = bf2f(hf[i]);
                const float e = __expf(-fraw), r = __builtin_amdgcn_rcpf(1.f + e);
                float f = (1.f + lbv * e) * r, kk = oml * e * r;
                if (padchunk && t < PADF) { f = 1.f; kk = 0.f; }
                run *= f; lp[i] = run; kv[i] = kk; qv[i] = siluf_(qraw); }
            TOT[tq * 128 + d] = run;
            if (c + 1 < 33) load_raw(c + 1);
            LBAR();
            const float t0 = TOT[d], t1 = TOT[128 + d], t2 = TOT[256 + d], t3 = TOT[384 + d];
            const float pre = (tq > 0 ? t0 : 1.f) * (tq > 1 ? t1 : 1.f) * (tq > 2 ? t2 : 1.f);
            const float cE = tq == 0 ? __builtin_amdgcn_rcpf(t0) * __builtin_amdgcn_rcpf(t1) : (tq == 1 ? __builtin_amdgcn_rcpf(t1) : (tq == 2 ? 1.f : t2));
            const float e63r = t2 * t3;
#pragma unroll
            for (int i4 = 0; i4 < 16; i4 += 4) { float kw[4];
#pragma unroll
                for (int ii = 0; ii < 4; ++ii) { const int i = i4 + ii, t = tq * 16 + i; const float E1 = lp[i] * cE, inv = __builtin_amdgcn_rcpf(E1);
                    const unsigned qq = pk2(qv[i] * E1, qv[i] * (pre * lp[i]));
                    QS[t * SD + d] = (bf16_t)(qq & 0xffffu); QX[t * SD + d] = (bf16_t)(qq >> 16); KS[t * SD + d] = (bf16_t)f2bf(kv[i] * inv); kw[ii] = kv[i] * inv * e63r; }
                *(LAS u32x2*)(KT + d * ST + tq * 16 + i4) = (u32x2){pk2(kw[0], kw[1]), pk2(kw[2], kw[3])}; }
            if (tq == 0) DEC[d] = (t0 * t1) * (t2 * t3);
        }
        if (MODE == 1) {
            const float c63 = CUM[63];
            const int ta_ = 2 * (tid & 31);
            const float cum0 = CUM[ta_], cum1 = CUM[ta_ + 1], dt0 = DTA[c * 64 + ta_], dt1 = DTA[c * 64 + ta_ + 1];
#pragma unroll
            for (int k = 0; k < 3; ++k) { const int pt = tid + 512 * k; if (pt < 1280) { const int cgq = pt >> 5, u = pt & 31, ta = 2 * u;
                float o[2][8]; unpack8(rrow[2 * k], o[0]); unpack8(rrow[2 * k + 1], o[1]);
                if (cgq < 8) { const int e0 = cgq * 8;
                    *(LAS u32x4*)(XS + ta * ST + e0) = rrow[2 * k]; *(LAS u32x4*)(XS + (ta + 1) * ST + e0) = rrow[2 * k + 1];
#pragma unroll
                    for (int j = 0; j < 8; ++j) *(LAS unsigned*)(VT + (e0 + j) * ST + ta) = pk2(o[0][j] * dt0, o[1][j] * dt1); }
                else if (cgq < 24) { const int n0 = (cgq - 8) * 8; const float wk0 = __expf(c63 - cum0), wk1 = __expf(c63 - cum1);
                    *(LAS u32x4*)(KS + ta * SD + n0) = rrow[2 * k]; *(LAS u32x4*)(KS + (ta + 1) * SD + n0) = rrow[2 * k + 1];
#pragma unroll
                    for (int j = 0; j < 8; ++j) *(LAS unsigned*)(KT + (n0 + j) * ST + ta) = pk2(o[0][j] * wk0, o[1][j] * wk1); }
                else { const int n0 = (cgq - 24) * 8; const float eq0 = __expf(cum0), eq1 = __expf(cum1);
                    *(LAS u32x4*)(QS + ta * SD + n0) = rrow[2 * k]; *(LAS u32x4*)(QS + (ta + 1) * SD + n0) = rrow[2 * k + 1];
#pragma unroll
                    for (int j = 0; j < 8; ++j) { o[0][j] *= eq0; o[1][j] *= eq1; }
                    *(LAS u32x4*)(QX + ta * SD + n0) = pack8(o[0]); *(LAS u32x4*)(QX + (ta + 1) * SD + n0) = pack8(o[1]); }
            } }
        }
        if (MODE != 2) { if (c + 1 < 33) load_raw(c + 1); }
        LBAR();
        {   const int mtS = w >> 1;
            f32x4 accS[2] = {(f32x4){0.f, 0.f, 0.f, 0.f}, (f32x4){0.f, 0.f, 0.f, 0.f}};
#pragma unroll
            for (int k0 = 0; k0 < DK; k0 += 32) { const bf16x8 qa = ldfrag(QS, mtS * 16 + r16, SD, k0 + q4 * 8);
#pragma unroll
                for (int i = 0; i < 2; ++i) accS[i] = MFMA16(qa, ldfrag(KS, ((w * 2 + i) & 3) * 16 + r16, SD, k0 + q4 * 8), accS[i]); }
            const f32x4 ct = *(const LAS f32x4*)(CUM + mtS * 16 + q4 * 4);
            float csv[2];
#pragma unroll
            for (int i = 0; i < 2; ++i) csv[i] = CUM[((w * 2 + i) & 3) * 16 + r16];
#pragma unroll
            for (int i = 0; i < 2; ++i) { const int s = ((w * 2 + i) & 3) * 16 + r16;
#pragma unroll
                for (int j = 0; j < 4; ++j) { const int t = mtS * 16 + q4 * 4 + j; const float v = (s <= t) ? accS[i][j] * __expf(ct[j] - csv[i]) : 0.f; PP[t * ST + s] = (bf16_t)f2bf(v); } }
        }
        LBAR();
        {   const int mtY = w >> 1;
            f32x4 accY[2] = {(f32x4){0.f, 0.f, 0.f, 0.f}, (f32x4){0.f, 0.f, 0.f, 0.f}};
#pragma unroll
            for (int k0 = 0; k0 < 64; k0 += 32) { const bf16x8 pa = ldfrag(PP, mtY * 16 + r16, ST, k0 + q4 * 8);
#pragma unroll
                for (int i = 0; i < 2; ++i) accY[i] = MFMA16(ldfrag(VT, ((w * 2 + i) & 3) * 16 + r16, ST, k0 + q4 * 8), pa, accY[i]); }
#pragma unroll
            for (int k0 = 0; k0 < DK; k0 += 32) { const bf16x8 qa = ldfrag(QX, mtY * 16 + r16, SD, k0 + q4 * 8);
#pragma unroll
                for (int i = 0; i < 2; ++i) accY[i] = MFMA16(ldfrag(STc, ((w * 2 + i) & 3) * 16 + r16, SD, k0 + q4 * 8), qa, accY[i]); }
            u32x2 xw[2];
            if (MODE == 1) {
#pragma unroll
                for (int i = 0; i < 2; ++i) xw[i] = *(const LAS u32x2*)(XS + (mtY * 16 + r16) * ST + ((w * 2 + i) & 3) * 16 + q4 * 4); }
            const float decs = MODE == 0 ? __expf(64.f * lg) : (MODE == 1 ? __expf(CUM[63]) : 1.f);
            f32x4 accT[TPW];
#pragma unroll
            for (int i = 0; i < TPW; ++i) { const int ti = w * TPW + i, mt = ti >> 2;
                if (MODE == 2) { const f32x4 dv = *(const LAS f32x4*)(DEC + mt * 16 + q4 * 4); accT[i] = st[i] * dv; } else accT[i] = st[i] * decs; }
#pragma unroll
            for (int k0 = 0; k0 < 64; k0 += 32)
#pragma unroll
                for (int i = 0; i < TPW; ++i) { const int ti = w * TPW + i, mt = ti >> 2, nt = ti & 3;
                    accT[i] = MFMA16(ldfrag(KT, mt * 16 + r16, ST, k0 + q4 * 8), ldfrag(VT, nt * 16 + r16, ST, k0 + q4 * 8), accT[i]); }
#pragma unroll
            for (int i = 0; i < 2; ++i) { const int nt = (w * 2 + i) & 3; f32x4 acc = accY[i];
                const int t = mtY * 16 + r16, e0 = nt * 16 + q4 * 4; const size_t row = row0 + t;
                if (MODE == 1) {
                    acc[0] = (acc[0] + Dh * bflo(xw[i].x)) * siluf_(bflo(zw[i].x)); acc[1] = (acc[1] + Dh * bfhi(xw[i].x)) * siluf_(bfhi(zw[i].x));
                    acc[2] = (acc[2] + Dh * bflo(xw[i].y)) * siluf_(bflo(zw[i].y)); acc[3] = (acc[3] + Dh * bfhi(xw[i].y)) * siluf_(bfhi(zw[i].y)); }
                *(u32x2*)(BR + row * LDBR + OBASE + e0) = (u32x2){pk2(acc[0], acc[1]), pk2(acc[2], acc[3])}; }
#pragma unroll
            for (int i = 0; i < TPW; ++i) { const int ti = w * TPW + i, mt = ti >> 2, nt = ti & 3; st[i] = accT[i];
                *(LAS u32x2*)(STn + (nt * 16 + r16) * SD + mt * 16 + q4 * 4) = (u32x2){pk2(accT[i][0], accT[i][1]), pk2(accT[i][2], accT[i][3])}; }
        }
        LBAR();
    }
}

constexpr int S_US = 0, S_BBT = 4608, S_CC = 20992, S_BU = 38400, S_X = 103936;
static_assert(S_X + 4 * 32 * 136 * 2 <= LDS_BYTES, "lds");
__device__ __forceinline__ void s5_unit(const Params& p, int l, int unit, LAS unsigned char* lds) {
    const int tid = opaque_tid(), lane = tid & 63, w = __builtin_amdgcn_readfirstlane(tid >> 6), r16 = lane & 15, q4 = lane >> 4;
    const int b = unit >> 3, gb = unit & 7;
    const bf16_t* MX = (const bf16_t*)(p.ws + WS_MX); bf16_t* S5P = (bf16_t*)(p.ws + WS_S5P);
    LAS bf16_t* US = (LAS bf16_t*)(lds + S_US); LAS bf16_t* BBT = (LAS bf16_t*)(lds + S_BBT); LAS bf16_t* CC = (LAS bf16_t*)(lds + S_CC); LAS float* BU = (LAS float*)(lds + S_BU); LAS bf16_t* X = (LAS bf16_t*)(lds + S_X);
    __syncthreads();
    float ar = 0.f, ai = 0.f, xr = 0.f, xi = 0.f;
    const int gi_s = tid >> 6, pp = tid & 63;
    if (tid < 256) {
        const int g = gb * 4 + gi_s, gp = (l * 32 + g) * 64 + pp;
        const float step = expf(p.in[19][l * 32 + g]), lr = p.in[12][gp], li = p.in[13][gp];
        const float mag = expf(lr * step); float sn, cs; sincos_turns(li * step * 0.15915494309f, sn, cs);
        ar = mag * cs; ai = mag * sn; const float inv = 1.f / (lr * lr + li * li);
        const float cor = ((ar - 1.f) * lr + ai * li) * inv, coi = (ai * lr - (ar - 1.f) * li) * inv;
#pragma unroll
        for (int j = 0; j < 16; ++j) { const float br = p.in[14][(size_t)gp * 16 + j], bi = p.in[15][(size_t)gp * 16 + j];
            BBT[(gi_s * 128 + pp) * 16 + j] = (bf16_t)f2bf(cor * br - coi * bi); BBT[(gi_s * 128 + 64 + pp) * 16 + j] = (bf16_t)f2bf(cor * bi + coi * br);
            CC[(gi_s * 16 + j) * 136 + pp] = (bf16_t)f2bf(p.in[16][((size_t)(l * 32 + g) * 16 + j) * 64 + pp]); CC[(gi_s * 16 + j) * 136 + 64 + pp] = (bf16_t)f2bf(-p.in[17][((size_t)(l * 32 + g) * 16 + j) * 64 + pp]); }
    }
    __syncthreads();
    const int gi_w = w >> 1, mt_w = w & 1;
    const float* dskp = p.in[18] + l * 512 + gb * 64 + gi_w * 16 + q4 * 4;
    auto urow = [&](int s) -> size_t { return (s < 2 ? (size_t)(s * 32) : (size_t)b * TP + s * 32) + mt_w * 16 + r16; };
    bf16x8 bbf[8], ccf[4];
#pragma unroll
    for (int nt = 0; nt < 8; ++nt) { bbf[nt] = (bf16x8){0, 0, 0, 0, 0, 0, 0, 0}; if (q4 < 2) bbf[nt] = ldfrag(BBT, gi_w * 128 + nt * 16 + r16, 16, q4 * 8); }
#pragma unroll
    for (int k = 0; k < 4; ++k) ccf[k] = ldfrag(CC, gi_w * 16 + r16, 136, k * 32 + q4 * 8);
    bf16x8 afr = (bf16x8){0, 0, 0, 0, 0, 0, 0, 0}; u32x2 uw;
    if (q4 < 2) afr = *(const bf16x8*)(MX + urow(0) * LDMX + S5U + gb * 64 + gi_w * 16 + q4 * 8);
    uw = *(const u32x2*)(MX + urow(0) * LDMX + S5U + gb * 64 + gi_w * 16 + q4 * 4);
    for (int s = 0; s < 66; ++s) {
        const size_t row0 = (size_t)b * TP + s * 32;
#pragma unroll
        for (int nt = 0; nt < 8; ++nt) {
            const f32x4 acc = MFMA16(afr, bbf[nt], ((f32x4){0.f, 0.f, 0.f, 0.f}));
#pragma unroll
            for (int j = 0; j < 4; ++j) BU[(gi_w * 32 + mt_w * 16 + q4 * 4 + j) * 128 + nt * 16 + r16] = acc[j]; }
        const u32x2 uwc = uw;
        if (s + 1 < 66) { if (q4 < 2) afr = *(const bf16x8*)(MX + urow(s + 1) * LDMX + S5U + gb * 64 + gi_w * 16 + q4 * 8);
            uw = *(const u32x2*)(MX + urow(s + 1) * LDMX + S5U + gb * 64 + gi_w * 16 + q4 * 4); }
        LBAR();
        if (tid < 256) {
            float bur_[32], bui_[32];
#pragma unroll
            for (int t = 0; t < 32; ++t) { bur_[t] = BU[(gi_s * 32 + t) * 128 + pp]; bui_[t] = BU[(gi_s * 32 + t) * 128 + 64 + pp]; }
#pragma unroll
            for (int t = 0; t < 32; ++t) { const float bur = bur_[t], bui = bui_[t];
                const float nxr = ar * xr - ai * xi + bur, nxi = ar * xi + ai * xr + bui; xr = nxr; xi = nxi;
                const unsigned pk = pk2(xr, xi); X[(gi_s * 32 + t) * 136 + pp] = (bf16_t)(pk & 0xffffu); X[(gi_s * 32 + t) * 136 + 64 + pp] = (bf16_t)(pk >> 16); } }
        LBAR();
        { f32x4 acc = (f32x4){0.f, 0.f, 0.f, 0.f};
#pragma unroll
            for (int k0 = 0; k0 < 128; k0 += 32) acc = MFMA16(ccf[k0 >> 5], ldfrag(X, gi_w * 32 + mt_w * 16 + r16, 136, k0 + q4 * 8), acc);
            const int t = mt_w * 16 + r16, ch = gi_w * 16 + q4 * 4;
            const f32x4 dsk = *(const f32x4*)dskp;
            const float y0 = geluf_(acc[0] + dsk[0] * bflo(uwc.x)), y1 = geluf_(acc[1] + dsk[1] * bfhi(uwc.x)), y2 = geluf_(acc[2] + dsk[2] * bflo(uwc.y)), y3 = geluf_(acc[3] + dsk[3] * bfhi(uwc.y));
            *(u32x2*)(S5P + (row0 + t) * 512 + gb * 64 + ch) = (u32x2){pk2(y0, y1), pk2(y2, y3)}; }
    }
    __syncthreads();
}

__device__ __forceinline__ void mixer_phase(const Params& p, int l, LAS unsigned char* lds) {
    const int G = gridDim.x, bx = blockIdx.x, wave = opaque_tid() >> 6;
    constexpr int N_SSD = 64, N_HG = FAST_HG ? 64 : 32, N_RET = FAST_RET ? 64 : 0, N_S5 = FAST_S5 ? 64 : 0, NW = N_SSD + N_HG + N_RET + N_S5;
    for (int u0 = bx; u0 < NW; u0 += G) { int u = u0;
        if (u < N_SSD) {
#if FAST_SSD
            attn_unit<1>(p, l, u, lds); if (MIXREP & 1) attn_unit<1>(p, l, u, lds);
#else
            ssd_simple(p, l, u, lds);
#endif
            continue; } u -= N_SSD;
        if (u < N_HG) {
#if FAST_HG
            attn_unit<2>(p, l, u, lds); if (MIXREP & 2) attn_unit<2>(p, l, u, lds);
#else
            hg_simple(p, l, u, lds);
#endif
            continue; } u -= N_HG;
#if FAST_RET
        if (u < N_RET) { attn_unit<0>(p, l, u, lds); if (MIXREP & 4) attn_unit<0>(p, l, u, lds); continue; } u -= N_RET;
#endif
#if FAST_S5
        s5_unit(p, l, u, lds); if (MIXREP & 8) s5_unit(p, l, u, lds);
#endif
    }
    constexpr int NV_S5 = FAST_S5 ? 0 : 256, NV_RET = FAST_RET ? 0 : 64, NV = NV_S5 + NV_RET;
    if (NV > 0) {
        const int nfree = G > NW ? G - NW : G, fb = G > NW ? bx - NW : bx;
        if (fb >= 0) for (int u = wave * nfree + fb; u < NV; u += 8 * nfree) {
#if !FAST_S5
            if (u < NV_S5) { s5_simple(p, l, u); continue; }
#endif
#if !FAST_RET
            ret_simple(p, l, u - NV_S5);
#endif
        }
    }
}

__global__ void __launch_bounds__(512, 2) fwd_megakernel(Params p_arg) {
    extern __shared__ __attribute__((aligned(16))) unsigned char smem[];
    LAS unsigned char* lds = (LAS unsigned char*)smem;
    cg::grid_group grid = cg::this_grid();
    const int G = gridDim.x, bx = blockIdx.x;
    volatile LAS unsigned* xst = (volatile LAS unsigned*)(lds + LDS_BYTES - 16);
    if (threadIdx.x == 0) { xst[0] = 0u; xst[1] = 0u; }
    __syncthreads();
    const XcdBarrier xb = xcd_barrier_post((unsigned*)(fetch_params().ws + WS_BAR), xst);
    if (PHMASK & 1) { const Params p = fetch_params(); norm_phase<0, false>(p, nullptr, p.in[5]);
    convert_layer(p, 0, lds); }
    if (fetch_params().out == nullptr) grid.sync();
    GSYNC();
    for (int l_ = 0; l_ < NLAYERS_RUN; ++l_) {
        int l = l_; asm volatile("" : "+s"(l));
        if (PHMASK & 2) {
            const Params p = fetch_params(); const char* ws = (const char*)p.ws;
            pg8::PlainOrder S{ws + WS_U, ws + WS_WIN, 1024, 1024, 64, NPROJ / 256, G, bx};
            pg8::EpiProj E{p.ws};
            for (int rp = 0; rp < ((REPMASK & 2) ? 2 : 1); ++rp) { if (rp) GSYNC(); pg8::gemm_phase(lds, 1024, 1024, 1024, S, E); }
            meta_proj(p, lds);
        }
        GSYNC();
        { const Params p = fetch_params(); conv_phase(p, l); }
        GSYNC();
        if (PHMASK & 4) { const Params p = fetch_params(); mixer_phase(p, l, lds); }
        if (REPMASK & 4) { GSYNC(); const Params p = fetch_params(); mixer_phase(p, l, lds); }
        GSYNC();
        if (PHMASK & 8) {
            const Params p = fetch_params(); const char* ws = (const char*)p.ws;
            post_phase(p, l);
            pg8::PlainOrder S{ws + WS_S5P, ws + WS_WGLU, 512, 512, 64, 4, G, bx};
            pg8::EpiGlu E{(bf16_t*)(p.ws + WS_BR), p.in[21] + l * 1024};
            for (int rp = 0; rp < ((REPMASK & 8) ? 2 : 1); ++rp) { if (rp) GSYNC(); pg8::gemm_phase(lds, 512, 512, 512, S, E); }
            meta_glu(p, l, lds);
        }
        GSYNC();
        if (PHMASK & 16) {
            const Params p = fetch_params(); const char* ws = (const char*)p.ws;
            pg8::MergeOrder S{ws + WS_BR, ws + WS_WBR, 64, 4, G, bx};
            pg8::EpiMerge E{(bf16_t*)(p.ws + WS_MIXP), (const bf16_t*)(p.ws + WS_G)};
            for (int rp = 0; rp < ((REPMASK & 16) ? 2 : 1); ++rp) { if (rp) GSYNC(); pg8::gemm_phase(lds, LDBR, 512, 512, S, E); }
            meta_merge(p, lds);
        }
        GSYNC();
        if (PHMASK & 32) {
            const Params p = fetch_params(); const char* ws = (const char*)p.ws;
            pg8::PlainOrder S{ws + WS_MIXP, ws + WS_WOUT, 1024, 1024, 64, 4, G, bx};
            pg8::EpiBf E{(bf16_t*)(p.ws + WS_DELTA), 1024};
            for (int rp = 0; rp < ((REPMASK & 32) ? 2 : 1); ++rp) { if (rp) GSYNC(); pg8::gemm_phase(lds, 1024, 1024, 1024, S, E); }
            meta_f32(p, (const bf16_t*)(p.ws + WS_MIXP), 1024, (const bf16_t*)(p.ws + WS_WOUT), lds);
        }
        GSYNC();
        if (PHMASK & 64) { const Params p = fetch_params(); norm_phase<1, false>(p, p.in[6] + l * 1024, p.in[7] + l * 1024); }
        GSYNC();
        if (PHMASK & 128) {
            const Params p = fetch_params(); const char* ws = (const char*)p.ws;
            pg8::PlainOrder S{ws + WS_U, ws + WS_WUP, 1024, 1024, 64, 16, G, bx};
            pg8::EpiUp E{(bf16_t*)(p.ws + WS_G), DFF};
            for (int rp = 0; rp < ((REPMASK & 128) ? 2 : 1); ++rp) { if (rp) GSYNC(); pg8::gemm_phase(lds, 1024, 1024, 1024, S, E); }
            meta_up(p, lds);
        }
        GSYNC();
        if (PHMASK & 256) {
            const Params p = fetch_params(); const char* ws = (const char*)p.ws;
            pg8::PlainOrder S{ws + WS_G, ws + WS_WDN, DFF, DFF, 64, 4, G, bx};
            pg8::EpiBf E{(bf16_t*)(p.ws + WS_DELTA), 1024};
            for (int rp = 0; rp < ((REPMASK & 256) ? 2 : 1); ++rp) { if (rp) GSYNC(); pg8::gemm_phase(lds, DFF, DFF, DFF, S, E); }
            meta_f32(p, (const bf16_t*)(p.ws + WS_G), DFF, (const bf16_t*)(p.ws + WS_WDN), lds);
        }
        GSYNC();
        for (int sr = 0; sr < SYNCREP; ++sr) GSYNC();
        { const Params p = fetch_params();
        if (l + 1 < DEPTH) { norm_phase<1, false>(p, p.in[8] + l * 1024, p.in[5] + (l + 1) * 1024); convert_layer(p, l + 1, lds); GSYNC(); }
        else norm_phase<1, true>(p, p.in[8] + l * 1024, nullptr); }
    }
}

extern "C" void kernel_launch(void* const* d_in, const int* in_sizes, int n_in, void* d_out, int out_size, void* d_ws, size_t ws_size, hipStream_t stream) {
    static int grid_blocks = 0;
    if (grid_blocks == 0) {
        if (n_in != 30 || ws_size < WS_TOTAL) { fprintf(stderr, "kernel_launch: unexpected inputs (n_in %d, ws %zu, need %zu)\n", n_in, ws_size, (size_t)WS_TOTAL); grid_blocks = -1; return; }
        int dev = 0, cus = 0, per_cu = 0;
        hipGetDevice(&dev);
        hipDeviceGetAttribute(&cus, hipDeviceAttributeMultiprocessorCount, dev);
        if (hipFuncSetAttribute((const void*)fwd_megakernel, hipFuncAttributeMaxDynamicSharedMemorySize, LDS_BYTES) != hipSuccess) fprintf(stderr, "kernel_launch: hipFuncSetAttribute failed\n");
        hipOccupancyMaxActiveBlocksPerMultiprocessor(&per_cu, (const void*)fwd_megakernel, 512, LDS_BYTES);
        if (per_cu < 1) { fprintf(stderr, "kernel_launch: occupancy query says %d\n", per_cu); per_cu = 1; }
        (void)hipGetLastError();
        grid_blocks = cus * per_cu;
    }
    if (grid_blocks < 0) return;
    if (hipMemsetAsync((unsigned char*)d_ws + WS_BAR, 0, XCD_BAR_WORDS * 4, stream) != hipSuccess) { fprintf(stderr, "kernel_launch: memset of the barrier words failed\n"); return; }
    Params p{};
    for (int i = 0; i < 30; ++i) p.in[i] = (const float*)d_in[i];
    p.out = (float*)d_out; p.ws = (unsigned char*)d_ws;
    void* args[] = {&p};
    hipError_t e = hipLaunchCooperativeKernel((const void*)fwd_megakernel, dim3(grid_blocks), dim3(512), args, LDS_BYTES, stream);
    if (e != hipSuccess) fprintf(stderr, "cooperative launch failed: %s (grid %d)\n", hipGetErrorString(e), grid_blocks);
}
```
